# Optimizing an MI355X kernel written in HIP

```python
import math
import jax
import jax.numpy as jnp
from jax import lax
import numpy as np

D_MODEL = 1024
BATCH = 16
SEQ = 2048
DEPTH = 2

GRID_W = 64
CTX_LEN = 256
N_MOD = 9
D_FF = 2816
S5_WIDTH = 512
S5_GROUP = 16
S5_GROUPS = S5_WIDTH // S5_GROUP
S5_STATE = 64
DN_HEADS = 8
DN_HEAD_DIM = 64
DN_WIDTH = DN_HEADS * DN_HEAD_DIM
DN_CONV = 5
DN_CHUNK = 64
STATE_COLS = S5_WIDTH + 3 * DN_WIDTH + 4 * DN_HEADS
IN_COLS = STATE_COLS + DN_WIDTH + 2 * D_MODEL
EPS = 1e-6

kernel_name = "hybrid_s5_gdn_macaron_prefix"


def rmsnorm(x, w):
    xf = x.astype(jnp.float32)
    xf = xf * lax.rsqrt(jnp.mean(xf * xf, axis=-1, keepdims=True) + EPS)
    return (xf * w.astype(jnp.float32)).astype(x.dtype)


def l2norm(x):
    xf = x.astype(jnp.float32)
    return xf * lax.rsqrt(jnp.sum(xf * xf, axis=-1, keepdims=True) + EPS)


def modulate(x, shift, scale):
    return x * (1.0 + scale) + shift


def swiglu(x, w_in, w_out):
    gate, up = jnp.split(x @ w_in, 2, axis=-1)
    return (jax.nn.silu(gate) * up) @ w_out


def to_colmajor(t, rows):
    b, n, ch = t.shape
    return t.reshape(b, rows, GRID_W, ch).transpose(0, 2, 1, 3).reshape(b, n, ch)


def from_colmajor(t, rows):
    b, n, ch = t.shape
    return t.reshape(b, GRID_W, rows, ch).transpose(0, 2, 1, 3).reshape(b, n, ch)


def centred_dwconv(x, w):
    k = w.shape[0]
    return lax.conv_general_dilated(
        x, w[:, None, :].astype(x.dtype), window_strides=(1,), padding=[(k // 2, k // 2)],
        dimension_numbers=("NWC", "WIO", "NWC"), feature_group_count=x.shape[-1])


def s5_discretise(lam_re, lam_im, log_dt, b_re, b_im):
    dt = jnp.exp(log_dt.astype(jnp.float32))[:, None]
    lr, li = lam_re.astype(jnp.float32), lam_im.astype(jnp.float32)
    mag = jnp.exp(lr * dt)
    a_re, a_im = mag * jnp.cos(li * dt), mag * jnp.sin(li * dt)
    den = lr * lr + li * li
    f_re = ((a_re - 1.0) * lr + a_im * li) / den
    f_im = (a_im * lr - (a_re - 1.0) * li) / den
    br, bi = b_re.astype(jnp.float32), b_im.astype(jnp.float32)
    bb_re = f_re[..., None] * br - f_im[..., None] * bi
    bb_im = f_re[..., None] * bi + f_im[..., None] * br
    return a_re, a_im, bb_re, bb_im


def _complex_affine_combine(e1, e2):
    a1r, a1i, b1r, b1i = e1
    a2r, a2i, b2r, b2i = e2
    return (a2r * a1r - a2i * a1i, a2r * a1i + a2i * a1r,
            a2r * b1r - a2i * b1i + b2r, a2r * b1i + a2i * b1r + b2i)


def s5_scan(ug, a_re, a_im, bb_re, bb_im, init, reverse):
    bu_re = jnp.einsum("blgh,gph->lbgp", ug, bb_re)
    bu_im = jnp.einsum("blgh,gph->lbgp", ug, bb_im)
    if init is not None:
        i_re, i_im = init
        first = -1 if reverse else 0
        bu_re = bu_re.at[first].add(a_re * i_re - a_im * i_im)
        bu_im = bu_im.at[first].add(a_re * i_im + a_im * i_re)
    n = bu_re.shape[0]
    ar = jnp.broadcast_to(a_re, (n, 1) + a_re.shape)
    ai = jnp.broadcast_to(a_im, (n, 1) + a_im.shape)
    _, _, s_re, s_im = lax.associative_scan(
        _complex_affine_combine, (ar, ai, bu_re, bu_im), reverse=reverse)
    last = 0 if reverse else n - 1
    return s_re, s_im, (s_re[last], s_im[last])


def s5_readout(s_re, s_im, c_re, c_im):
    return (jnp.einsum("lbgp,ghp->blgh", s_re, c_re.astype(jnp.float32))
            - jnp.einsum("lbgp,ghp->blgh", s_im, c_im.astype(jnp.float32)))


def s5_mixer(u_lat, u_ctx, lam_re, lam_im, log_dt, b_re, b_im, c_re, c_im, d_skip, w_glu, b_glu, ctx_out):
    def grouped(u):
        return u.astype(jnp.float32).reshape(u.shape[0], u.shape[1], S5_GROUPS, S5_GROUP)
    ug, ucg = grouped(u_lat), grouped(u_ctx)
    dg = d_skip.astype(jnp.float32).reshape(S5_GROUPS, S5_GROUP)
    y_lat = ug * dg
    y_ctx = ucg * dg if ctx_out else None
    for d in range(2):
        rev = d == 1
        a_re, a_im, bb_re, bb_im = s5_discretise(lam_re[d], lam_im[d], log_dt[d], b_re[d], b_im[d])
        sc_re, sc_im, ctx_final = s5_scan(ucg, a_re, a_im, bb_re, bb_im, None, rev)
        sl_re, sl_im, _ = s5_scan(ug, a_re, a_im, bb_re, bb_im, ctx_final, rev)
        y_lat = y_lat + s5_readout(sl_re, sl_im, c_re[d], c_im[d])
        if ctx_out:
            y_ctx = y_ctx + s5_readout(sc_re, sc_im, c_re[d], c_im[d])

    def glu(y, like):
        y = jax.nn.gelu(y.reshape(like.shape)).astype(like.dtype)
        return y * jax.nn.sigmoid(y @ w_glu + b_glu)
    return glu(y_lat, u_lat), (glu(y_ctx, u_ctx) if ctx_out else None)


def gated_delta_chunked(q, k, v, g, beta, s0):
    b, n, h, dk = q.shape
    dv = v.shape[-1]
    nc = n // DN_CHUNK

    def chunks(t):
        return t.reshape(b, nc, DN_CHUNK, h, -1).transpose(1, 0, 3, 2, 4)
    q, k, v = chunks(q), chunks(k), chunks(v)
    g = g.reshape(b, nc, DN_CHUNK, h).transpose(1, 0, 3, 2)
    beta = beta.reshape(b, nc, DN_CHUNK, h).transpose(1, 0, 3, 2)
    gcum = jnp.cumsum(g, axis=-1)
    idx = jnp.arange(DN_CHUNK)
    incl = idx[:, None] >= idx[None, :]
    strict = idx[:, None] > idx[None, :]
    diff = gcum[..., :, None] - gcum[..., None, :]
    decay = jnp.where(incl, jnp.exp(jnp.where(incl, diff, 0.0)), 0.0)
    kb = k * beta[..., None]
    lmat = jnp.where(strict, jnp.einsum("nbhid,nbhjd->nbhij", kb, k) * decay, 0.0)
    eye = jnp.eye(DN_CHUNK, dtype=q.dtype)
    rhs = jnp.concatenate([v * beta[..., None], kb * jnp.exp(gcum)[..., None]], axis=-1)
    sol = lax.linalg.triangular_solve(eye + lmat, rhs, left_side=True, lower=True, unit_diagonal=True)
    v_w, k_cd = sol[..., :dv], sol[..., dv:]
    attn = jnp.where(incl, jnp.einsum("nbhid,nbhjd->nbhij", q, k) * decay, 0.0)
    q_dec = q * jnp.exp(gcum)[..., None]
    k_dec = k * jnp.exp(gcum[..., -1:] - gcum)[..., None]
    g_last = jnp.exp(gcum[..., -1])[..., None, None]
    if s0 is None:
        s0 = jnp.zeros((b, h, dk, dv), jnp.float32)

    def step(state, xs):
        v_w_i, k_cd_i, attn_i, q_i, k_i, gl_i = xs
        v_new = v_w_i - jnp.einsum("bhcd,bhde->bhce", k_cd_i, state)
        out = jnp.einsum("bhcd,bhde->bhce", q_i, state) + jnp.einsum("bhij,bhje->bhie", attn_i, v_new)
        state = state * gl_i + jnp.einsum("bhcd,bhce->bhde", k_i, v_new)
        return state, out
    s_final, o = lax.scan(step, s0, (v_w, k_cd, attn, q_dec, k_dec, g_last))
    o = o.transpose(1, 0, 3, 2, 4).reshape(b, n, h, dv)
    return o, s_final


def gdn_prepare(t, conv_w, a_log, dt_bias):
    b, n, _ = t.shape
    qkv = jax.nn.silu(centred_dwconv(t[..., :3 * DN_WIDTH], conv_w))
    q, k, v = jnp.split(qkv, 3, axis=-1)
    q = l2norm(q.reshape(b, n, DN_HEADS, DN_HEAD_DIM)) * DN_HEAD_DIM ** -0.5
    k = l2norm(k.reshape(b, n, DN_HEADS, DN_HEAD_DIM))
    v = v.reshape(b, n, DN_HEADS, DN_HEAD_DIM).astype(jnp.float32)
    a = t[..., 3 * DN_WIDTH:3 * DN_WIDTH + 2 * DN_HEADS].astype(jnp.float32).reshape(b, n, 2, DN_HEADS)
    bt = t[..., 3 * DN_WIDTH + 2 * DN_HEADS:].astype(jnp.float32).reshape(b, n, 2, DN_HEADS)
    g = -jnp.exp(a_log.astype(jnp.float32)) * jax.nn.softplus(a + dt_bias.astype(jnp.float32))
    beta = jax.nn.sigmoid(bt)
    return q, k, v, g, beta


def gdn_mixer(t_lat, t_ctx, z_lat, z_ctx, conv_w, a_log, dt_bias, norm_w, rows, ctx_out):
    lat = gdn_prepare(to_colmajor(t_lat, rows), conv_w, a_log, dt_bias)
    pctx = gdn_prepare(t_ctx, conv_w, a_log, dt_bias)
    o_lat, o_ctx = 0.0, 0.0
    for d in range(2):
        def orient(tensor):
            return jnp.flip(tensor, axis=1) if d == 1 else tensor

        def direction(prep):
            q, k, v, g, beta = prep
            return orient(q), orient(k), orient(v), orient(g[:, :, d]), orient(beta[:, :, d])
        oc, ctx_state = gated_delta_chunked(*direction(pctx), None)
        ol, _ = gated_delta_chunked(*direction(lat), ctx_state)
        o_lat = o_lat + orient(ol)
        if ctx_out:
            o_ctx = o_ctx + orient(oc)

    def finish(o, z):
        o = rmsnorm(o, norm_w).reshape(o.shape[0], o.shape[1], DN_WIDTH)
        return o, jax.nn.silu(z.astype(jnp.float32))
    on, gz = finish(o_lat, z_lat)
    y_lat = (from_colmajor(on, rows) * gz).astype(z_lat.dtype)
    y_ctx = None
    if ctx_out:
        onc, gzc = finish(o_ctx, z_ctx)
        y_ctx = (onc * gzc).astype(z_ctx.dtype)
    return y_lat, y_ctx


def merge_branches(gate_logits, y_a, y_b, w_pa, w_pb, w_o):
    g_a, g_b = jnp.split(jax.nn.sigmoid(gate_logits), 2, axis=-1)
    return (g_a * (y_a @ w_pa) + g_b * (y_b @ w_pb)) @ w_o


def setup_inputs(seed: int = 0) -> dict:
    key = jax.random.key(seed)
    keys = iter(jax.random.split(key, 40))

    def normal(shape, scale):
        return jax.random.normal(next(keys), shape, jnp.float32) * scale

    def uniform(shape, lo, hi):
        return jax.random.uniform(next(keys), shape, jnp.float32, lo, hi)

    def gain(shape):
        return 1.0 + normal(shape, 0.02)

    L, D = DEPTH, D_MODEL
    G, P, H = S5_GROUPS, S5_STATE, S5_GROUP
    state_index = jnp.arange(S5_STATE, dtype=jnp.float32)
    inputs = {}
    inputs["x"] = normal((BATCH, SEQ, D), 1.0)
    inputs["c"] = normal((BATCH, D), 1.0)
    inputs["ctx"] = normal((BATCH, CTX_LEN, D), 1.0)
    inputs["c_ctx"] = normal((D,), 1.0)
    inputs["w_mod"] = normal((L, D, N_MOD * D), 0.5 * D ** -0.5)
    inputs["b_mod"] = normal((L, N_MOD * D), 0.02)
    inputs["ffn1_norm"] = gain((L, D))
    inputs["ffn1_w_in"] = normal((L, D, 2 * D_FF), D ** -0.5)
    inputs["ffn1_w_out"] = normal((L, D_FF, D), D_FF ** -0.5)
    inputs["mix_norm"] = gain((L, D))
    inputs["w_in"] = normal((L, D, IN_COLS), D ** -0.5)
    inputs["s5_lam_re"] = -0.5 * jnp.exp(normal((L, 2, G, P), 0.05))
    inputs["s5_lam_im"] = math.pi * state_index + normal((L, 2, G, P), 0.05)
    inputs["s5_log_dt"] = uniform((L, 2, G), math.log(1e-3), math.log(1e-1))
    inputs["s5_b_re"] = normal((L, 2, G, P, H), (2 * H) ** -0.5)
    inputs["s5_b_im"] = normal((L, 2, G, P, H), (2 * H) ** -0.5)
    inputs["s5_c_re"] = normal((L, 2, G, H, P), 0.5)
    inputs["s5_c_im"] = normal((L, 2, G, H, P), 0.5)
    inputs["s5_d"] = normal((L, S5_WIDTH), 0.5)
    inputs["s5_w_glu"] = normal((L, S5_WIDTH, S5_WIDTH), S5_WIDTH ** -0.5)
    inputs["s5_b_glu"] = normal((L, S5_WIDTH), 0.02)
    inputs["dn_conv_w"] = normal((L, DN_CONV, 3 * DN_WIDTH), DN_CONV ** -0.5)
    inputs["dn_a_log"] = jnp.log(uniform((L, 2, DN_HEADS), 1.0, 16.0))
    dn_dt = jnp.exp(uniform((L, 2, DN_HEADS), math.log(1e-3), math.log(1e-1)))
    inputs["dn_dt_bias"] = dn_dt + jnp.log(-jnp.expm1(-dn_dt))
    inputs["dn_norm"] = gain((L, DN_HEAD_DIM))
    inputs["w_proj_a"] = normal((L, S5_WIDTH, D), S5_WIDTH ** -0.5)
    inputs["w_proj_b"] = normal((L, DN_WIDTH, D), DN_WIDTH ** -0.5)
    inputs["w_out"] = normal((L, D, D), D ** -0.5)
    inputs["ffn2_norm"] = gain((L, D))
    inputs["ffn2_w_in"] = normal((L, D, 2 * D_FF), D ** -0.5)
    inputs["ffn2_w_out"] = normal((L, D_FF, D), D_FF ** -0.5)
    inputs["final_norm"] = gain((D,))
    return inputs


def reference(x, c, ctx, c_ctx, w_mod, b_mod, ffn1_norm, ffn1_w_in, ffn1_w_out, mix_norm, w_in,
              s5_lam_re, s5_lam_im, s5_log_dt, s5_b_re, s5_b_im, s5_c_re, s5_c_im, s5_d, s5_w_glu, s5_b_glu,
              dn_conv_w, dn_a_log, dn_dt_bias, dn_norm, w_proj_a, w_proj_b, w_out,
              ffn2_norm, ffn2_w_in, ffn2_w_out, final_norm):
    rows = x.shape[1] // GRID_W
    h, hc = x, ctx
    for l in range(DEPTH):
        last = l == DEPTH - 1
        ml = (jax.nn.silu(c) @ w_mod[l] + b_mod[l]).reshape(c.shape[0], N_MOD, 1, D_MODEL)
        mc = (jax.nn.silu(c_ctx) @ w_mod[l] + b_mod[l]).reshape(N_MOD, 1, D_MODEL)

        h = h + 0.5 * ml[:, 2] * swiglu(modulate(rmsnorm(h, ffn1_norm[l]), ml[:, 0], ml[:, 1]),
                                        ffn1_w_in[l], ffn1_w_out[l])
        hc = hc + 0.5 * mc[2] * swiglu(modulate(rmsnorm(hc, ffn1_norm[l]), mc[0], mc[1]),
                                       ffn1_w_in[l], ffn1_w_out[l])

        p = modulate(rmsnorm(h, mix_norm[l]), ml[:, 3], ml[:, 4]) @ w_in[l]
        pc = modulate(rmsnorm(hc, mix_norm[l]), mc[3], mc[4]) @ (w_in[l][:, :STATE_COLS] if last else w_in[l])

        y_a, yc_a = s5_mixer(p[..., :S5_WIDTH], pc[..., :S5_WIDTH],
                             s5_lam_re[l], s5_lam_im[l], s5_log_dt[l], s5_b_re[l], s5_b_im[l],
                             s5_c_re[l], s5_c_im[l], s5_d[l], s5_w_glu[l], s5_b_glu[l], not last)
        y_b, yc_b = gdn_mixer(p[..., S5_WIDTH:STATE_COLS], pc[..., S5_WIDTH:STATE_COLS],
                              p[..., STATE_COLS:STATE_COLS + DN_WIDTH],
                              None if last else pc[..., STATE_COLS:STATE_COLS + DN_WIDTH],
                              dn_conv_w[l], dn_a_log[l], dn_dt_bias[l], dn_norm[l], rows, not last)
        h = h + ml[:, 5] * merge_branches(p[..., STATE_COLS + DN_WIDTH:], y_a, y_b,
                                          w_proj_a[l], w_proj_b[l], w_out[l])

        h = h + 0.5 * ml[:, 8] * swiglu(modulate(rmsnorm(h, ffn2_norm[l]), ml[:, 6], ml[:, 7]),
                                        ffn2_w_in[l], ffn2_w_out[l])
        if not last:
            hc = hc + mc[5] * merge_branches(pc[..., STATE_COLS + DN_WIDTH:], yc_a, yc_b,
                                             w_proj_a[l], w_proj_b[l], w_out[l])
            hc = hc + 0.5 * mc[8] * swiglu(modulate(rmsnorm(hc, ffn2_norm[l]), mc[6], mc[7]),
                                           ffn2_w_in[l], ffn2_w_out[l])
    return rmsnorm(h, final_norm)
```

```cpp
#include <hip/hip_runtime.h>
#include <hip/hip_cooperative_groups.h>
#include <cstdio>
#include <cstdint>
namespace cg = cooperative_groups;
namespace pg8 {
#define PG8_LAS __attribute__((address_space(3)))
typedef unsigned short bf16_t;
typedef short bf16x8 __attribute__((ext_vector_type(8)));
typedef float f32x4 __attribute__((ext_vector_type(4)));
typedef unsigned u32x4 __attribute__((ext_vector_type(4)));
constexpr int BM = 256, BK = 64, HALF = 128, HTB = HALF * BK * 2  , STAGE_BYTES = 8 * HTB, NXCD = 8, WGM = 8;

__host__ __device__ __forceinline__ int lds_byte(int r, int c) { const int st = (r >> 4) * 2 + (c >> 5), rr = r & 15, cc = c & 31, ob = rr * 64 + cc * 2; return st * 1024 + (ob ^ (((ob >> 9) & 1) << 5)); }
__host__ __device__ __forceinline__ void stage_rc(int b, int& R, int& C) { const int st = b / 1024, sb = b % 1024, swz = sb ^ (((sb >> 9) & 1) << 5); R = (st >> 1) * 16 + swz / 64; C = (st & 1) * 32 + (swz % 64) / 2; }
__host__ __device__ __forceinline__ int perm32(int rho) { const int n = rho >> 4, i = rho & 15; return 8 * (i >> 2) + 4 * n + (i & 3); }

struct Unit { int pm, pn; };
struct Gemm { const bf16_t* A; const bf16_t* Bt; int M, N, K; };

struct StaticOrder {
    int nM, nN, nwg, G, c;
    __host__ __device__ void init(int M, int N, int G_, int c_) { nM = M / BM; nN = N / BM; nwg = nM * nN; G = G_; c = c_; }
    __host__ __device__ bool next(int i, Unit& u) const {
        const long L = (long)i * G + c; if (L >= nwg) return false;
        int wgid = (int)L; { const int q = nwg / NXCD, r = nwg % NXCD, xcd = wgid % NXCD, off = wgid / NXCD; wgid = (xcd < r ? xcd * (q + 1) : r * (q + 1) + (xcd - r) * q) + off; }
        const int nig = WGM * nN, gid = wgid / nig, fm = gid * WGM, gsz = (nM - fm) < WGM ? (nM - fm) : WGM;
        u.pm = fm + ((wgid % nig) % gsz); u.pn = (wgid % nig) / gsz; return true;
    }
    __device__ __forceinline__ void a_ready(const Unit&) const {}
    __device__ __forceinline__ void done(const Unit&) const {}
};
__device__ __forceinline__ unsigned cvt_pk_bf16(float lo, float hi) { unsigned r; asm volatile("v_cvt_pk_bf16_f32 %0, %1, %2" : "=v"(r) : "v"(lo), "v"(hi)); return r; }
template <class Epi, class Sched, bool ALIGN_EPI = false, bool SP2 = false>
__device__ __forceinline__ void gemm_phase(PG8_LAS unsigned char* lds, const Gemm g, const Sched& S, const Epi& E) {
    int tid_ = threadIdx.x; asm volatile("" : "+v"(tid_)); const int tid = tid_, wid = __builtin_amdgcn_readfirstlane(tid >> 6), lane = tid & 63, wr = wid >> 2, wc = wid & 3, fr = lane & 15, fq = lane >> 4;
    const int K = g.K, nt = K / BK;
    unsigned voffA[2], voffB[2];
#pragma unroll
    for (int i = 0; i < 2; ++i) { int R, C; stage_rc(tid * 16 + i * 8192, R, C); const int Rb = Epi::PERM ? ((R & ~31) + perm32(R & 31)) : R;
        voffA[i] = (unsigned)(R * K + C) * 2u; voffB[i] = (unsigned)(Rb * K + C) * 2u; }
    const size_t kstep = (size_t)(BK * 2);
    const size_t hstep = (size_t)HALF * K * 2;
    const size_t tstep = 2 * hstep;
    const unsigned ldsw = (unsigned)wid * 1024u;
    const int aoff = lds_byte(wr * 64 + fr, fq * 8), boff = lds_byte(wc * 32 + fr, fq * 8);
#define PG8_SA(b, h) (((b) * 2 + (h)) * HTB)
#define PG8_SB(b, h) ((4 + (b) * 2 + (h)) * HTB)
#define PG8_STAGE(bufoff, gbase, voff) do { _Pragma("unroll") for (int _i = 0; _i < 2; ++_i) \
        __builtin_amdgcn_global_load_lds((const unsigned*)((const char*)(gbase) + (voff)[_i]), (PG8_LAS unsigned*)(lds + (bufoff) + ldsw + _i * 8192), 16, 0, 0); } while (0)
#define PG8_LDA(dst, b, h) do { _Pragma("unroll") for (int m = 0; m < 4; ++m) _Pragma("unroll") for (int k = 0; k < 2; ++k) dst[m][k] = *(const PG8_LAS bf16x8*)(lds + PG8_SA(b, h) + aoff + m * 2048 + k * 1024); } while (0)
#define PG8_LDB(dst, b, h) do { _Pragma("unroll") for (int n = 0; n < 2; ++n) _Pragma("unroll") for (int k = 0; k < 2; ++k) dst[n][k] = *(const PG8_LAS bf16x8*)(lds + PG8_SB(b, h) + boff + n * 2048 + k * 1024); } while (0)
#define PG8_MMA(ai, bj, At, Bt) do { __builtin_amdgcn_s_setprio(1); _Pragma("unroll") for (int m = 0; m < 4; ++m) _Pragma("unroll") for (int n = 0; n < 2; ++n) _Pragma("unroll") for (int k = 0; k < 2; ++k) \
        acc[ai][bj][m][n] = __builtin_amdgcn_mfma_f32_16x16x32_bf16(Bt[n][k], At[m][k], acc[ai][bj][m][n], 0, 0, 0); __builtin_amdgcn_s_setprio(0); } while (0)
#define PG8_WAIT_V(n) asm volatile("s_waitcnt vmcnt(" #n ")" ::: "memory")
#define PG8_WAIT_L(n) asm volatile("s_waitcnt lgkmcnt(" #n ")" ::: "memory")
#define PG8_BAR __builtin_amdgcn_s_barrier()
#define PG8_SCHED __builtin_amdgcn_sched_barrier(0)
    Unit cur, nxt; int ui = 0;
    if (!S.next(0, cur)) return;
    f32x4 acc[2][2][4][2];
#pragma unroll
    for (int a = 0; a < 2; ++a)
#pragma unroll
        for (int b = 0; b < 2; ++b)
#pragma unroll
            for (int m = 0; m < 4; ++m)
#pragma unroll
                for (int n = 0; n < 2; ++n) acc[a][b][m][n] = (f32x4){0.f, 0.f, 0.f, 0.f};
    bf16x8 At[4][2], B0[2][2], B1[2][2];
    const char* cA = (const char*)g.A + (size_t)cur.pm * tstep; const char* cB = (const char*)g.Bt + (size_t)cur.pn * tstep;
    S.a_ready(cur);
    if constexpr (SP2) {
        PG8_STAGE(PG8_SB(0, 0), cB, voffB); PG8_STAGE(PG8_SB(0, 1), cB + hstep, voffB); PG8_STAGE(PG8_SA(0, 0), cA, voffA); PG8_STAGE(PG8_SA(0, 1), cA + hstep, voffA);
        if (wr == 1) PG8_BAR;
        PG8_WAIT_V(2); PG8_BAR;
        PG8_STAGE(PG8_SB(1, 0), cB + kstep, voffB); PG8_STAGE(PG8_SA(1, 0), cA + kstep, voffA); PG8_STAGE(PG8_SB(1, 1), cB + hstep + kstep, voffB);
        PG8_WAIT_V(6); PG8_BAR;
    } else {
        PG8_STAGE(PG8_SB(0, 0), cB, voffB); PG8_STAGE(PG8_SA(0, 0), cA, voffA); PG8_STAGE(PG8_SB(0, 1), cB + hstep, voffB); PG8_STAGE(PG8_SA(0, 1), cA + hstep, voffA);
        if (wr == 1) PG8_BAR;
        PG8_WAIT_V(4); PG8_BAR;
        PG8_STAGE(PG8_SB(1, 0), cB + kstep, voffB); PG8_STAGE(PG8_SA(1, 0), cA + kstep, voffA); PG8_STAGE(PG8_SB(1, 1), cB + hstep + kstep, voffB);
        PG8_WAIT_V(6); PG8_BAR;
    }
    for (;;) {
        const bool has_next = S.next(ui + 1, nxt);
        const char* nA = has_next ? (const char*)g.A + (size_t)nxt.pm * tstep : cA; const char* nB = has_next ? (const char*)g.Bt + (size_t)nxt.pn * tstep : cB;
        for (int t = 0; t < nt; t += 2) {
            const bool last = (t == nt - 2);
            const char* a1 = cA + (size_t)(t + 1) * kstep;
            const char* a2 = last ? nA : cA + (size_t)(t + 2) * kstep; const char* b2 = last ? nB : cB + (size_t)(t + 2) * kstep;
            const char* a3 = a2 + kstep; const char* b3 = b2 + kstep;
            if (last && has_next) S.a_ready(nxt);
            if constexpr (SP2) {
            PG8_LDB(B0, 0, 0); PG8_LDB(B1, 0, 1); PG8_SCHED; PG8_LDA(At, 0, 0); PG8_STAGE(PG8_SA(1, 1), a1 + hstep, voffA);
            PG8_WAIT_V(8); PG8_WAIT_L(0); PG8_BAR; PG8_MMA(0, 0, At, B0); PG8_MMA(0, 1, At, B1); PG8_BAR; PG8_SCHED;
            PG8_LDA(At, 0, 1); PG8_STAGE(PG8_SB(0, 0), b2, voffB); PG8_STAGE(PG8_SB(0, 1), b2 + hstep, voffB); PG8_STAGE(PG8_SA(0, 0), a2, voffA);
            PG8_WAIT_V(8); PG8_WAIT_L(0); PG8_BAR; PG8_MMA(1, 0, At, B0); PG8_MMA(1, 1, At, B1); PG8_BAR; PG8_SCHED;
            PG8_LDB(B0, 1, 0); PG8_LDB(B1, 1, 1); PG8_SCHED; PG8_LDA(At, 1, 0); PG8_STAGE(PG8_SA(0, 1), a2 + hstep, voffA);
            PG8_WAIT_V(8); PG8_WAIT_L(0); PG8_BAR; PG8_MMA(0, 0, At, B0); PG8_MMA(0, 1, At, B1); PG8_BAR; PG8_SCHED;
            PG8_LDA(At, 1, 1); PG8_STAGE(PG8_SB(1, 0), b3, voffB); PG8_STAGE(PG8_SB(1, 1), b3 + hstep, voffB); PG8_STAGE(PG8_SA(1, 0), a3, voffA);
            PG8_WAIT_V(8); PG8_WAIT_L(0); PG8_BAR; PG8_MMA(1, 0, At, B0); PG8_MMA(1, 1, At, B1); PG8_BAR; PG8_SCHED;
            } else {
            PG8_LDB(B0, 0, 0); PG8_SCHED; PG8_LDA(At, 0, 0); PG8_STAGE(PG8_SA(1, 1), a1 + hstep, voffA);
            PG8_WAIT_L(8); PG8_BAR; PG8_WAIT_L(0); PG8_MMA(0, 0, At, B0); PG8_BAR; PG8_SCHED;
            PG8_LDB(B1, 0, 1); PG8_STAGE(PG8_SB(0, 0), b2, voffB);
            PG8_BAR; PG8_WAIT_L(0); PG8_MMA(0, 1, At, B1); PG8_BAR;
            PG8_LDA(At, 0, 1); PG8_STAGE(PG8_SA(0, 0), a2, voffA);
            PG8_BAR; PG8_WAIT_L(0); PG8_MMA(1, 0, At, B0); PG8_BAR; PG8_SCHED;
            PG8_STAGE(PG8_SB(0, 1), b2 + hstep, voffB);
            PG8_WAIT_V(6); PG8_BAR; PG8_MMA(1, 1, At, B1); PG8_BAR;
            PG8_LDB(B0, 1, 0); PG8_SCHED; PG8_LDA(At, 1, 0); PG8_STAGE(PG8_SA(0, 1), a2 + hstep, voffA);
            PG8_WAIT_L(8); PG8_BAR; PG8_WAIT_L(0); PG8_MMA(0, 0, At, B0); PG8_BAR; PG8_SCHED;
            PG8_LDB(B1, 1, 1); PG8_STAGE(PG8_SB(1, 0), b3, voffB);
            PG8_BAR; PG8_WAIT_L(0); PG8_MMA(0, 1, At, B1); PG8_BAR;
            PG8_LDA(At, 1, 1); PG8_STAGE(PG8_SA(1, 0), a3, voffA);
            PG8_BAR; PG8_WAIT_L(0); PG8_MMA(1, 0, At, B0); PG8_BAR; PG8_SCHED;
            PG8_STAGE(PG8_SB(1, 1), b3 + hstep, voffB);
            PG8_WAIT_V(6); PG8_BAR; PG8_MMA(1, 1, At, B1); PG8_BAR;
            }
        }
        if constexpr (ALIGN_EPI) { if (wr == 0) PG8_BAR; }
        if constexpr (!Epi::AFTER_DRAIN) { E(acc, cur, wr, wc, fr, fq); S.done(cur); }
        if (!has_next) break;
#pragma unroll
        for (int a = 0; a < 2; ++a)
#pragma unroll
            for (int b = 0; b < 2; ++b)
#pragma unroll
                for (int m = 0; m < 4; ++m)
#pragma unroll
                    for (int n = 0; n < 2; ++n) acc[a][b][m][n] = (f32x4){0.f, 0.f, 0.f, 0.f};
        cur = nxt; cA = nA; cB = nB; ++ui;
        if constexpr (ALIGN_EPI) { if (wr == 1) PG8_BAR; }
    }
    PG8_WAIT_V(0);
    if constexpr (!ALIGN_EPI) { if (wr == 0) PG8_BAR; }
    PG8_BAR;
    if constexpr (Epi::AFTER_DRAIN) { E.fused(acc, cur, wr, wc, fr, fq, lds, wid, lane); S.done(cur); }
#undef PG8_SA
#undef PG8_SB
#undef PG8_STAGE
#undef PG8_LDA
#undef PG8_LDB
#undef PG8_MMA
#undef PG8_WAIT_V
#undef PG8_WAIT_L
#undef PG8_BAR
#undef PG8_SCHED
}
}
#define LAS __attribute__((address_space(3)))
typedef unsigned short bf16_t;
typedef short bf16x8 __attribute__((ext_vector_type(8)));
typedef float f32x4 __attribute__((ext_vector_type(4)));
typedef unsigned u32x4 __attribute__((ext_vector_type(4)));
typedef unsigned u32x2 __attribute__((ext_vector_type(2)));

constexpr int D = 1024, NB = 16, SEQ = 2048, CTXL = 256, DEPTH = 2, DFF = 2816;
constexpr int ML = NB * SEQ, MC = NB * CTXL, MALL = ML + MC;
constexpr int NWIN = 4864;
constexpr int NT = 512;
constexpr float EPS = 1e-6f;
constexpr size_t MiB = 1u << 20;
constexpr size_t WS_MOD = 0;
constexpr size_t WS_W1A = 2 * MiB, WS_W1B = 13 * MiB, WS_WIN = 19 * MiB, WS_WGLU = 29 * MiB, WS_WPA = 30 * MiB, WS_WPB = 31 * MiB, WS_WO = 32 * MiB, WS_W2A = 34 * MiB, WS_W2B = 45 * MiB;
constexpr size_t WS_HC = 51 * MiB, WS_XN = 67 * MiB, WS_YAP = 67 * MiB, WS_O0 = 103 * MiB;
constexpr size_t WS_U = 139 * MiB, WS_QKV = 175 * MiB, WS_Z = 283 * MiB, WS_G = 319 * MiB, WS_AB = 463 * MiB, WS_HID = 139 * MiB;
constexpr size_t WS_FREE = 468 * MiB, WS_O1 = WS_U, WS_MRG = WS_QKV, WS_END = 504 * MiB;
constexpr int LDS_BYTES = 159744;

typedef __bf16 bf16x2_t __attribute__((ext_vector_type(2)));
typedef float f32x2_t __attribute__((ext_vector_type(2)));
__device__ __forceinline__ unsigned pk2(float lo, float hi) { const f32x2_t v = {lo, hi}; const bf16x2_t b = __builtin_convertvector(v, bf16x2_t); return __builtin_bit_cast(unsigned, b); }
__device__ __forceinline__ float bf2f(unsigned short b) { return __uint_as_float(((unsigned)b) << 16); }
__device__ __forceinline__ float bflo(unsigned w) { return __uint_as_float(w << 16); }
__device__ __forceinline__ float bfhi(unsigned w) { return __uint_as_float(w & 0xffff0000u); }
__device__ __forceinline__ bf16_t f2bf(float f) { return (bf16_t)(pk2(f, 0.f) & 0xffffu); }
__device__ __forceinline__ float sigmoidf_(float x) { return __builtin_amdgcn_rcpf(1.0f + __expf(-x)); }
__device__ __forceinline__ float siluf_(float x) { return x * sigmoidf_(x); }
__device__ __forceinline__ float gelu_tanh(float x) { const float z = 0.7978845608028654f * (x + 0.044715f * x * x * x); const float t = 1.0f - 2.0f * __builtin_amdgcn_rcpf(1.0f + __expf(2.0f * z)); return 0.5f * x * (1.0f + t); }
__device__ __forceinline__ float wave_sum(float v) {
#pragma unroll
    for (int o = 1; o < 64; o <<= 1) v += __shfl_xor(v, o);
    return v;
}
__device__ __forceinline__ int opaque_tid() { int t = threadIdx.x; asm volatile("" : "+v"(t)); return t; }
#define LDS_WAIT() asm volatile("s_waitcnt lgkmcnt(0)" ::: "memory")

struct Args { const float* in[34]; };
__device__ __forceinline__ int opaque_zero() { int z = 0; asm volatile("" : "+v"(z)); return __builtin_amdgcn_readfirstlane(z); }
#define CAS __attribute__((address_space(4)))
#define KARG(i) (*(const float* const CAS*)((const CAS char*)__builtin_amdgcn_kernarg_segment_ptr() + 8 * ((i) + opaque_zero())))
#define WSB() ((unsigned char*)KARG(33))
#define WSO(off) ((unsigned char*)KARG(33) + ((size_t)(unsigned)((int)((off) >> 20) + opaque_zero()) << 20))
#define INP(i) KARG(i)

struct EpiSwiGLU {
    static constexpr bool PERM = true, AFTER_DRAIN = false;
    bf16_t* H;
    __device__ __forceinline__ void operator()(const f32x4 (&acc)[2][2][4][2], const pg8::Unit& u, int wr, int wc, int fr, int fq) const {
        const int row0 = u.pm * 256 + wr * 64 + fr, col0 = u.pn * 128 + wc * 32 + 8 * fq;
#pragma unroll
        for (int ai = 0; ai < 2; ++ai)
#pragma unroll
            for (int m = 0; m < 4; ++m) {
                bf16_t* rowp = H + (size_t)(row0 + ai * 128 + m * 16) * DFF + col0;
                const f32x4 g0 = acc[ai][0][m][0], g1 = acc[ai][0][m][1], u0 = acc[ai][1][m][0], u1 = acc[ai][1][m][1];
                u32x4 w;
                w.x = pk2(siluf_(g0[0]) * u0[0], siluf_(g0[1]) * u0[1]); w.y = pk2(siluf_(g0[2]) * u0[2], siluf_(g0[3]) * u0[3]);
                w.z = pk2(siluf_(g1[0]) * u1[0], siluf_(g1[1]) * u1[1]); w.w = pk2(siluf_(g1[2]) * u1[2], siluf_(g1[3]) * u1[3]);
                *(u32x4*)rowp = w;
            }
    }
};
struct EpiResid {
    static constexpr bool PERM = false, AFTER_DRAIN = false;
    const float* src_lat; const float* src_ctx; float* dst_lat; float* dst_ctx; const float* gate; float coef; int row_base;
    __device__ __forceinline__ void operator()(const f32x4 (&acc)[2][2][4][2], const pg8::Unit& u, int wr, int wc, int fr, int fq) const {
        const int rowt = row_base + u.pm * 256; const bool lat = rowt < ML;
        const float* sp = lat ? src_lat + (size_t)rowt * D : src_ctx + (size_t)(rowt - ML) * D;
        float* dp = lat ? dst_lat + (size_t)rowt * D : dst_ctx + (size_t)(rowt - ML) * D;
        const int b = lat ? (rowt >> 11) : 16;
        const int rl = wr * 64 + fr, col0 = u.pn * 256 + wc * 32 + 4 * fq;
        f32x4 gv[2][2];
#pragma unroll
        for (int bj = 0; bj < 2; ++bj)
#pragma unroll
            for (int n = 0; n < 2; ++n) gv[bj][n] = *(const f32x4*)(gate + (size_t)b * 9216 + col0 + bj * 128 + n * 16) * coef;
#pragma unroll
        for (int ai = 0; ai < 2; ++ai)
#pragma unroll
            for (int m = 0; m < 4; ++m) { const size_t off = (size_t)(rl + ai * 128 + m * 16) * D + col0;
#pragma unroll
                for (int bj = 0; bj < 2; ++bj)
#pragma unroll
                    for (int n = 0; n < 2; ++n) { const f32x4 s = *(const f32x4*)(sp + off + bj * 128 + n * 16); *(f32x4*)(dp + off + bj * 128 + n * 16) = s + gv[bj][n] * acc[ai][bj][m][n]; }
                if (m == 3) asm volatile("" ::: "memory"); }
    }
};
struct EpiWin {
    static constexpr bool PERM = true, AFTER_DRAIN = false;
    bf16_t* U; bf16_t* QKV; bf16_t* Z; bf16_t* G; float* AB;
    __device__ __forceinline__ void operator()(const f32x4 (&acc)[2][2][4][2], const pg8::Unit& u, int wr, int wc, int fr, int fq) const {
        const int row0 = u.pm * 256 + wr * 64 + fr, cw = wc * 32 + 8 * fq; const int pn = u.pn;
        if (pn == 18) {
            if (wc == 0) {
#pragma unroll
                for (int ai = 0; ai < 2; ++ai)
#pragma unroll
                    for (int m = 0; m < 4; ++m) { float* rp = AB + (size_t)(row0 + ai * 128 + m * 16) * 32 + 8 * fq; *(f32x4*)rp = acc[ai][0][m][0]; *(f32x4*)(rp + 4) = acc[ai][0][m][1]; }
            }
            return;
        }
        bf16_t* base; int ld, ct; bool sg = false;
        if (pn < 2) { base = U; ld = 512; ct = pn; } else if (pn < 8) { base = QKV; ld = 1536; ct = pn - 2; } else if (pn < 10) { base = Z; ld = 512; ct = pn - 8; } else { base = G; ld = 2048; ct = pn - 10; sg = true; }
#pragma unroll
        for (int ai = 0; ai < 2; ++ai)
#pragma unroll
            for (int m = 0; m < 4; ++m) { bf16_t* rowp = base + (size_t)(row0 + ai * 128 + m * 16) * ld + ct * 256 + cw;
#pragma unroll
                for (int bj = 0; bj < 2; ++bj) { f32x4 v0 = acc[ai][bj][m][0], v1 = acc[ai][bj][m][1];
                    if (sg) {
#pragma unroll
                        for (int j = 0; j < 4; ++j) { v0[j] = sigmoidf_(v0[j]); v1[j] = sigmoidf_(v1[j]); } }
                    u32x4 w; w.x = pk2(v0[0], v0[1]); w.y = pk2(v0[2], v0[3]); w.z = pk2(v1[0], v1[1]); w.w = pk2(v1[2], v1[3]);
                    *(u32x4*)(rowp + bj * 128) = w; } }
    }
};
struct EpiGLU {
    static constexpr bool PERM = true, AFTER_DRAIN = false;
    const bf16_t* pre; bf16_t* out; const float* bias;
    __device__ __forceinline__ void operator()(const f32x4 (&acc)[2][2][4][2], const pg8::Unit& u, int wr, int wc, int fr, int fq) const {
        const int row0 = u.pm * 256 + wr * 64 + fr, col0 = u.pn * 256 + wc * 32 + 8 * fq;
#pragma unroll
        for (int bj = 0; bj < 2; ++bj) { const f32x4 b0 = *(const f32x4*)(bias + col0 + bj * 128), b1 = *(const f32x4*)(bias + col0 + bj * 128 + 4);
#pragma unroll
            for (int ai = 0; ai < 2; ++ai)
#pragma unroll
                for (int m = 0; m < 4; ++m) { const size_t off = (size_t)(row0 + ai * 128 + m * 16) * 512 + col0 + bj * 128;
                    const u32x4 p = *(const u32x4*)(pre + off); const f32x4 v0 = acc[ai][bj][m][0] + b0, v1 = acc[ai][bj][m][1] + b1;
                    u32x4 w;
                    w.x = pk2(bflo(p.x) * sigmoidf_(v0[0]), bfhi(p.x) * sigmoidf_(v0[1])); w.y = pk2(bflo(p.y) * sigmoidf_(v0[2]), bfhi(p.y) * sigmoidf_(v0[3]));
                    w.z = pk2(bflo(p.z) * sigmoidf_(v1[0]), bfhi(p.z) * sigmoidf_(v1[1])); w.w = pk2(bflo(p.w) * sigmoidf_(v1[2]), bfhi(p.w) * sigmoidf_(v1[3]));
                    *(u32x4*)(out + off) = w; } }
    }
};
template <int PASS> struct EpiMerge {
    static constexpr bool PERM = true, AFTER_DRAIN = false;
    const bf16_t* G; bf16_t* MRG;
    __device__ __forceinline__ void operator()(const f32x4 (&acc)[2][2][4][2], const pg8::Unit& u, int wr, int wc, int fr, int fq) const {
        const int row0 = u.pm * 256 + wr * 64 + fr, col0 = u.pn * 256 + wc * 32 + 8 * fq;
#pragma unroll
        for (int ai = 0; ai < 2; ++ai)
#pragma unroll
            for (int m = 0; m < 4; ++m) { const size_t row = (size_t)(row0 + ai * 128 + m * 16);
#pragma unroll
                for (int bj = 0; bj < 2; ++bj) { const u32x4 g = *(const u32x4*)(G + row * 2048 + PASS * 1024 + col0 + bj * 128); bf16_t* op = MRG + row * 1024 + col0 + bj * 128;
                    const f32x4 v0 = acc[ai][bj][m][0], v1 = acc[ai][bj][m][1];
                    float r0 = bflo(g.x) * v0[0], r1 = bfhi(g.x) * v0[1], r2 = bflo(g.y) * v0[2], r3 = bfhi(g.y) * v0[3], r4 = bflo(g.z) * v1[0], r5 = bfhi(g.z) * v1[1], r6 = bflo(g.w) * v1[2], r7 = bfhi(g.w) * v1[3];
                    if (PASS) { const u32x4 o = *(const u32x4*)op; r0 += bflo(o.x); r1 += bfhi(o.x); r2 += bflo(o.y); r3 += bfhi(o.y); r4 += bflo(o.z); r5 += bfhi(o.z); r6 += bflo(o.w); r7 += bfhi(o.w); }
                    u32x4 w; w.x = pk2(r0, r1); w.y = pk2(r2, r3); w.z = pk2(r4, r5); w.w = pk2(r6, r7);
                    *(u32x4*)op = w; } }
    }
};
__device__ __forceinline__ void phase_mod(const Args& a, LAS unsigned char* lds, float* MOD) {
    LAS float* sc = (LAS float*)lds; LAS float* part = sc + 17 * 1024;
    const int tid = opaque_tid();
    const float* c = INP(1); const float* cc = INP(3);
    for (int i = tid; i < 17 * 1024; i += NT) { const float v = i < 16 * 1024 ? c[i] : cc[i - 16 * 1024]; sc[i] = siluf_(v); }
    __syncthreads();
    const int col = tid & 63, ks = tid >> 6;
    for (int item = blockIdx.x; item < 288; item += gridDim.x) {
        const int l = item / 144, n0 = (item % 144) * 64;
        const float* W = INP(4) + (size_t)l * 1024 * 9216 + n0 + col;
        float acc[17];
#pragma unroll
        for (int r = 0; r < 17; ++r) acc[r] = 0.f;
        for (int k0 = ks * 128; k0 < ks * 128 + 128; k0 += 16) { float w[16];
#pragma unroll
            for (int u = 0; u < 16; ++u) w[u] = W[(size_t)(k0 + u) * 9216];
#pragma unroll
            for (int u = 0; u < 16; ++u)
#pragma unroll
                for (int r = 0; r < 17; ++r) acc[r] += sc[r * 1024 + k0 + u] * w[u]; }
#pragma unroll
        for (int r = 0; r < 17; ++r) part[(ks * 17 + r) * 64 + col] = acc[r];
        __syncthreads();
        for (int o = tid; o < 17 * 64; o += NT) { const int r = o >> 6, cl = o & 63; float s = INP(5)[l * 9216 + n0 + cl];
#pragma unroll
            for (int q = 0; q < 8; ++q) s += part[(q * 17 + r) * 64 + cl];
            MOD[(size_t)(l * 17 + r) * 9216 + n0 + cl] = s; }
        __syncthreads();
    }
}

__device__ __forceinline__ int map_col(int type, int dn0) {
    if (type == 0) return dn0;
    if (type == 1) { const int tile = dn0 >> 8, w = dn0 & 255; return w < 128 ? tile * 128 + w : DFF + tile * 128 + (w - 128); }
    if (dn0 < 2048) return dn0;
    if (dn0 < 2560) return 2080 + (dn0 - 2048);
    if (dn0 < 4608) return 2592 + (dn0 - 2560);
    if (dn0 < 4640) return 2048 + (dn0 - 4608);
    return -1;
}
__device__ __forceinline__ void conv_matrix(const float* W, int K, int Nsrc, int Ndst, bf16_t* WT, int type, LAS float* scr, int gw, int NGW, int lane) {
    const int nblk = Ndst / 32, nitems = (K / 64) * nblk;
    for (int item = gw; item < nitems; item += NGW) {
        const int kb = item / nblk, nb = item % nblk, k0 = 64 * kb, dn0 = 32 * nb, sn0 = map_col(type, dn0);
        if (sn0 >= 0) {
            float wv[32];
#pragma unroll
            for (int i = 0; i < 32; ++i) wv[i] = W[(size_t)(k0 + 2 * i + (lane >> 5)) * Nsrc + sn0 + (lane & 31)];
#pragma unroll
            for (int i = 0; i < 32; ++i) scr[(2 * i + (lane >> 5)) * 33 + (lane & 31)] = wv[i];
        } else {
#pragma unroll 8
            for (int i = 0; i < 32; ++i) { const int kk = 2 * i + (lane >> 5); scr[kk * 33 + (lane & 31)] = 0.f; }
        }
        LDS_WAIT();
        const int c = lane & 7;
#pragma unroll
        for (int j = 0; j < 4; ++j) { const int n = (lane >> 3) + 8 * j; const LAS float* s = scr + (8 * c) * 33 + n;
            u32x4 o; o.x = pk2(s[0 * 33], s[1 * 33]); o.y = pk2(s[2 * 33], s[3 * 33]); o.z = pk2(s[4 * 33], s[5 * 33]); o.w = pk2(s[6 * 33], s[7 * 33]);
            *(u32x4*)(WT + (size_t)(dn0 + n) * K + k0 + 8 * c) = o; }
        LDS_WAIT();
    }
}
__device__ __forceinline__ void phase_convert_part(const Args& a, int l, LAS unsigned char* lds, int part, int blk, int nblk) {
    const int tid = opaque_tid(), lane = tid & 63, wave = tid >> 6;
    LAS float* scr = (LAS float*)(lds + wave * 16384);
    const int gw = blk * 8 + wave, NGW = nblk * 8;
    if (part == 0) {
        conv_matrix(INP(7) + (size_t)l * D * 2 * DFF, D, 2 * DFF, 2 * DFF, (bf16_t*)WSO(WS_W1A), 1, scr, gw, NGW, lane);
        conv_matrix(INP(8) + (size_t)l * DFF * D, DFF, D, D, (bf16_t*)WSO(WS_W1B), 0, scr, gw, NGW, lane);
        conv_matrix(INP(10) + (size_t)l * D * 4640, D, 4640, NWIN, (bf16_t*)WSO(WS_WIN), 2, scr, gw, NGW, lane);
    } else {
        conv_matrix(INP(19) + (size_t)l * 512 * 512, 512, 512, 512, (bf16_t*)WSO(WS_WGLU), 0, scr, gw, NGW, lane);
        conv_matrix(INP(25) + (size_t)l * 512 * D, 512, D, D, (bf16_t*)WSO(WS_WPA), 0, scr, gw, NGW, lane);
        conv_matrix(INP(26) + (size_t)l * 512 * D, 512, D, D, (bf16_t*)WSO(WS_WPB), 0, scr, gw, NGW, lane);
        conv_matrix(INP(27) + (size_t)l * D * D, D, D, D, (bf16_t*)WSO(WS_WO), 0, scr, gw, NGW, lane);
        conv_matrix(INP(29) + (size_t)l * D * 2 * DFF, D, 2 * DFF, 2 * DFF, (bf16_t*)WSO(WS_W2A), 1, scr, gw, NGW, lane);
        conv_matrix(INP(30) + (size_t)l * DFF * D, DFF, D, D, (bf16_t*)WSO(WS_W2B), 0, scr, gw, NGW, lane);
    }
}

__device__ __forceinline__ void phase_norm_range(const float* src_lat, const float* src_ctx, const float* nw, const float* modl, int shift_idx, int scale_idx, bf16_t* XN, int r_begin, int r_end, int blk, int nblk) {
    const int tid = opaque_tid(), lane = tid & 63, wave = tid >> 6;
    const int gw = blk * 8 + wave, NGW = nblk * 8;
    for (int rp = (r_begin >> 2) + gw; rp < (r_end >> 2); rp += NGW) {
        f32x4 v[4][4]; float ss[4] = {0.f, 0.f, 0.f, 0.f};
        const int row0 = 4 * rp; const bool lat = row0 < ML;
        const float* xr = lat ? src_lat + (size_t)row0 * D : src_ctx + (size_t)(row0 - ML) * D; const int b = lat ? (row0 >> 11) : 16;
#pragma unroll
        for (int u = 0; u < 4; ++u)
#pragma unroll
            for (int j = 0; j < 4; ++j) v[u][j] = *(const f32x4*)(xr + u * D + lane * 4 + 256 * j);
#pragma unroll
        for (int u = 0; u < 4; ++u)
#pragma unroll
            for (int j = 0; j < 4; ++j) ss[u] += (v[u][j].x * v[u][j].x + v[u][j].y * v[u][j].y) + (v[u][j].z * v[u][j].z + v[u][j].w * v[u][j].w);
        float rr[4];
#pragma unroll
        for (int u = 0; u < 4; ++u) rr[u] = rsqrtf(wave_sum(ss[u]) * (1.0f / D) + EPS);
        const float* sh = modl + (size_t)b * 9216 + shift_idx * 1024; const float* scl = modl + (size_t)b * 9216 + scale_idx * 1024;
#pragma unroll
        for (int j = 0; j < 4; ++j) { const int col = lane * 4 + 256 * j;
            const f32x4 w = *(const f32x4*)(nw + col), s1 = *(const f32x4*)(scl + col), s0 = *(const f32x4*)(sh + col);
            const f32x4 g = w * (s1 + 1.0f);
#pragma unroll
            for (int u = 0; u < 4; ++u) { const f32x4 y = v[u][j] * rr[u] * g + s0; u32x2 o; o.x = pk2(y.x, y.y); o.y = pk2(y.z, y.w); *(u32x2*)(XN + (size_t)(row0 + u) * D + col) = o; } }
    }
}
__device__ __forceinline__ void phase_norm(const float* src_lat, const float* src_ctx, const float* nw, const float* modl, int shift_idx, int scale_idx, bf16_t* XN, int M) {
    phase_norm_range(src_lat, src_ctx, nw, modl, shift_idx, scale_idx, XN, 0, M, (int)blockIdx.x, (int)gridDim.x);
}
__device__ __forceinline__ void phase_final(float* h, const float* nw) {
    const int tid = opaque_tid(), lane = tid & 63, wave = tid >> 6;
    const int gw = blockIdx.x * 8 + wave, NGW = gridDim.x * 8;
    for (int rp = gw; rp < (ML >> 1); rp += NGW) {
        float* xr = h + (size_t)(2 * rp) * D;
        f32x4 v[2][4]; float ss[2] = {0.f, 0.f};
#pragma unroll
        for (int u = 0; u < 2; ++u)
#pragma unroll
            for (int j = 0; j < 4; ++j) v[u][j] = *(const f32x4*)(xr + u * D + lane * 4 + 256 * j);
#pragma unroll
        for (int u = 0; u < 2; ++u)
#pragma unroll
            for (int j = 0; j < 4; ++j) ss[u] += (v[u][j].x * v[u][j].x + v[u][j].y * v[u][j].y) + (v[u][j].z * v[u][j].z + v[u][j].w * v[u][j].w);
        const float r0 = rsqrtf(wave_sum(ss[0]) * (1.0f / D) + EPS), r1 = rsqrtf(wave_sum(ss[1]) * (1.0f / D) + EPS);
#pragma unroll
        for (int j = 0; j < 4; ++j) { const int col = lane * 4 + 256 * j; const f32x4 w = *(const f32x4*)(nw + col);
            *(f32x4*)(xr + col) = v[0][j] * r0 * w; *(f32x4*)(xr + D + col) = v[1][j] * r1 * w; }
    }
}
__device__ __forceinline__ void phase_s5_combine(bf16_t* Y0, const bf16_t* Y1, int M) {
    const size_t nvec = (size_t)M * 512 / 8, stride = (size_t)gridDim.x * NT;
    for (size_t i = (size_t)blockIdx.x * NT + opaque_tid(); i < nvec; i += 4 * stride) {
        u32x4 p[4], q[4];
#pragma unroll
        for (int u = 0; u < 4; ++u) { const size_t k = i + u * stride; if (k < nvec) { p[u] = *(const u32x4*)(Y0 + k * 8); q[u] = *(const u32x4*)(Y1 + k * 8); } }
#pragma unroll
        for (int u = 0; u < 4; ++u) { const size_t k = i + u * stride; if (k < nvec) { u32x4 w;
            w.x = pk2(gelu_tanh(bflo(p[u].x) + bflo(q[u].x)), gelu_tanh(bfhi(p[u].x) + bfhi(q[u].x)));
            w.y = pk2(gelu_tanh(bflo(p[u].y) + bflo(q[u].y)), gelu_tanh(bfhi(p[u].y) + bfhi(q[u].y)));
            w.z = pk2(gelu_tanh(bflo(p[u].z) + bflo(q[u].z)), gelu_tanh(bfhi(p[u].z) + bfhi(q[u].z)));
            w.w = pk2(gelu_tanh(bflo(p[u].w) + bflo(q[u].w)), gelu_tanh(bfhi(p[u].w) + bfhi(q[u].w)));
            *(u32x4*)(Y0 + k * 8) = w; } }
    }
}
__device__ __forceinline__ void phase_gdn_finish(bf16_t* O0, const bf16_t* O1, const bf16_t* Z, const float* dnw, int M, int blk, int nblk) {
    const int tid = opaque_tid(), lane = tid & 63, wave = tid >> 6;
    const int gw = blk * 8 + wave, NGW = nblk * 8;
    const f32x4 w0 = *(const f32x4*)(dnw + (lane & 7) * 8), w1 = *(const f32x4*)(dnw + (lane & 7) * 8 + 4);
    const float ww[8] = { w0.x, w0.y, w0.z, w0.w, w1.x, w1.y, w1.z, w1.w };
    for (int rp = gw; rp < (M >> 2); rp += NGW) {
        u32x4 p[4], q[4], z[4];
#pragma unroll
        for (int u = 0; u < 4; ++u) { const size_t off = (size_t)(4 * rp + u) * 512 + lane * 8; p[u] = *(const u32x4*)(O0 + off); q[u] = *(const u32x4*)(O1 + off); z[u] = *(const u32x4*)(Z + off); }
#pragma unroll
        for (int u = 0; u < 4; ++u) { const size_t off = (size_t)(4 * rp + u) * 512 + lane * 8;
            float o[8] = { bflo(p[u].x) + bflo(q[u].x), bfhi(p[u].x) + bfhi(q[u].x), bflo(p[u].y) + bflo(q[u].y), bfhi(p[u].y) + bfhi(q[u].y), bflo(p[u].z) + bflo(q[u].z), bfhi(p[u].z) + bfhi(q[u].z), bflo(p[u].w) + bflo(q[u].w), bfhi(p[u].w) + bfhi(q[u].w) };
            float ss = 0.f;
#pragma unroll
            for (int j = 0; j < 8; ++j) ss += o[j] * o[j];
            ss += __shfl_xor(ss, 1); ss += __shfl_xor(ss, 2); ss += __shfl_xor(ss, 4);
            const float rn = rsqrtf(ss * (1.0f / 64.0f) + EPS);
            const float zz[8] = { bflo(z[u].x), bfhi(z[u].x), bflo(z[u].y), bfhi(z[u].y), bflo(z[u].z), bfhi(z[u].z), bflo(z[u].w), bfhi(z[u].w) };
            float y[8];
#pragma unroll
            for (int j = 0; j < 8; ++j) y[j] = o[j] * rn * ww[j] * siluf_(zz[j]);
            u32x4 w; w.x = pk2(y[0], y[1]); w.y = pk2(y[2], y[3]); w.z = pk2(y[4], y[5]); w.w = pk2(y[6], y[7]);
            *(u32x4*)(O0 + off) = w; }
    }
}
__device__ __forceinline__ int s5_row(int b, int dir, int n) {
    if (n < CTXL) { const int s = dir ? (CTXL - 1 - n) : n; return ML + b * CTXL + s; }
    const int t = n - CTXL; return b * SEQ + (dir ? (SEQ - 1 - t) : t);
}
#define MFMA16(A_, B_, C_) __builtin_amdgcn_mfma_f32_16x16x32_bf16((A_), (B_), (C_), 0, 0, 0)
__device__ __forceinline__ void phase_s5(const Args& a, int l, LAS unsigned char* lds, const bf16_t* U, bf16_t* Y0, bf16_t* Y1) {
    const int tid = opaque_tid(), lane = tid & 63, wave = __builtin_amdgcn_readfirstlane(tid >> 6), fr = lane & 15, fq = lane >> 4;
    LAS unsigned char* PB0 = lds + (wave >> 1) * 34816; LAS unsigned char* EX = lds + 139264 + wave * 1024; LAS unsigned char* YB = lds + 147456 + wave * 1024;
    const float* lam_re = INP(11); const float* lam_im = INP(12); const float* log_dt = INP(13); const float* b_re = INP(14); const float* b_im = INP(15);
    const float* c_re = INP(16); const float* c_im = INP(17); const float* s5d = INP(18);
    for (int task = blockIdx.x * 8 + wave; task < 2048; task += gridDim.x * 8) {
        const int b = task >> 7, g = (task >> 2) & 31, dir = (task >> 1) & 1, half = task & 1;
        const int pidx = (l * 2 + dir) * 32 + g;
        const float dt = expf(log_dt[pidx]);
        float are[2], aim[2], a8r[2], a8i[2]; bf16x8 Ybb[2][2];
#pragma unroll
        for (int nt = 0; nt < 2; ++nt) {
            const int p = 16 * (2 * half + nt) + fr;
            const float lr = lam_re[pidx * 64 + p], li = lam_im[pidx * 64 + p];
            const float mag = expf(lr * dt), ar = mag * cosf(li * dt), ai = mag * sinf(li * dt), den = lr * lr + li * li;
            const float fre = ((ar - 1.0f) * lr + ai * li) / den, fim = (ai * lr - (ar - 1.0f) * li) / den;
            are[nt] = ar; aim[nt] = ai;
            const float a2r = ar * ar - ai * ai, a2i = 2.0f * ar * ai, a4r = a2r * a2r - a2i * a2i, a4i = 2.0f * a2r * a2i;
            a8r[nt] = a4r * a4r - a4i * a4i; a8i[nt] = 2.0f * a4r * a4i;
            u32x4 wre = {0u, 0u, 0u, 0u}, wim = {0u, 0u, 0u, 0u};
            if (fq < 2) {
                const float* br = b_re + ((size_t)pidx * 64 + p) * 16 + 8 * fq; const float* bi = b_im + ((size_t)pidx * 64 + p) * 16 + 8 * fq;
                float re[8], im[8];
#pragma unroll
                for (int j = 0; j < 8; ++j) { re[j] = fre * br[j] - fim * bi[j]; im[j] = fre * bi[j] + fim * br[j]; }
                wre.x = pk2(re[0], re[1]); wre.y = pk2(re[2], re[3]); wre.z = pk2(re[4], re[5]); wre.w = pk2(re[6], re[7]);
                wim.x = pk2(im[0], im[1]); wim.y = pk2(im[2], im[3]); wim.z = pk2(im[4], im[5]); wim.w = pk2(im[6], im[7]);
            }
            Ybb[nt][0] = __builtin_bit_cast(bf16x8, wre); Ybb[nt][1] = __builtin_bit_cast(bf16x8, wim);
        }
        bf16x8 Yc[4];
#pragma unroll
        for (int ks = 0; ks < 4; ++ks) { const int pf = 4 * ks + fq; float v[8];
#pragma unroll
            for (int j = 0; j < 8; ++j) { const int nt = j >> 1, p = 16 * nt + pf; const size_t ci = ((size_t)pidx * 16 + fr) * 64 + p; v[j] = (j & 1) ? -c_im[ci] : c_re[ci]; }
            u32x4 w; w.x = pk2(v[0], v[1]); w.y = pk2(v[2], v[3]); w.z = pk2(v[4], v[5]); w.w = pk2(v[6], v[7]); Yc[ks] = __builtin_bit_cast(bf16x8, w); }
        const float dsk = s5d[l * 512 + g * 16 + fr];
        bf16_t* Yd = dir ? Y1 : Y0;
        const bool dskip = (dir == 0);
        float cyr[2] = {0.f, 0.f}, cyi[2] = {0.f, 0.f};
        bf16x8 Ydg;
        { float v[8];
#pragma unroll
          for (int j = 0; j < 8; ++j) v[j] = (fq < 2 && 8 * fq + j == fr) ? dsk : 0.f;
          u32x4 w; w.x = pk2(v[0], v[1]); w.y = pk2(v[2], v[3]); w.z = pk2(v[4], v[5]); w.w = pk2(v[6], v[7]); Ydg = __builtin_bit_cast(bf16x8, w); }
        float a16r[2], a16i[2];
#pragma unroll
        for (int nt = 0; nt < 2; ++nt) { a16r[nt] = a8r[nt] * a8r[nt] - a8i[nt] * a8i[nt]; a16i[nt] = 2.0f * a8r[nt] * a8i[nt]; }
        u32x4 nXu[4];
        const int sgn = dir ? -1 : 1;
        const int offU0 = sgn * ((fr >> 2) * 16 + (fr & 3)) * 512 + g * 16 + 8 * (fq & 1), dU = sgn * 4 * 512;
        const int offN0 = sgn * (32 * half + fr) * 512 + g * 16 + 8 * (fq & 1), offN1 = offN0 + sgn * 16 * 512;
        const int offY = sgn * (32 * half + (lane >> 1)) * 512 + g * 16 + 8 * (lane & 1);
#define S5_PREFETCH(N0) do { const bf16_t* Ub_ = U + (size_t)__builtin_amdgcn_readfirstlane(s5_row(b, dir, (N0))) * 512; \
            _Pragma("unroll") for (int m_ = 0; m_ < 4; ++m_) { nXu[m_] = (u32x4){0u, 0u, 0u, 0u}; if (fq < 2) nXu[m_] = *(const u32x4*)(Ub_ + offU0 + m_ * dU); } } while (0)
        S5_PREFETCH(0);
        for (int c = 0; c < 36; ++c) {
            const int n0 = 64 * c;
            LAS unsigned char* PB = PB0 + (c & 1) * 17408;
            bf16x8 Xu[4], Xn[2];
#pragma unroll
            for (int mt = 0; mt < 4; ++mt) Xu[mt] = __builtin_bit_cast(bf16x8, nXu[mt]);
            { u32x4 t0 = {0u, 0u, 0u, 0u}, t1 = t0;
              if (fq < 2 && dskip) { const bf16_t* Ub_ = U + (size_t)__builtin_amdgcn_readfirstlane(s5_row(b, dir, n0)) * 512; t0 = *(const u32x4*)(Ub_ + offN0); t1 = *(const u32x4*)(Ub_ + offN1); }
              Xn[0] = __builtin_bit_cast(bf16x8, t0); Xn[1] = __builtin_bit_cast(bf16x8, t1); }
            if (c + 1 < 36) S5_PREFETCH(n0 + 64);
            float Fre[2], Fim[2];
#pragma unroll
            for (int nt = 0; nt < 2; ++nt) {
                const float ar = are[nt], ai = aim[nt];
                f32x4 bu[4][2];
#pragma unroll
                for (int mt = 0; mt < 4; ++mt)
#pragma unroll
                    for (int ri = 0; ri < 2; ++ri) bu[mt][ri] = MFMA16(Xu[mt], Ybb[nt][ri], ((f32x4){0.f, 0.f, 0.f, 0.f}));
                float s_r = 0.f, s_i = 0.f;
#pragma unroll
                for (int tt = 0; tt < 16; ++tt) { const float br = bu[tt >> 2][0][tt & 3], bi = bu[tt >> 2][1][tt & 3];
                    const float nr = ar * s_r - ai * s_i + br, ni = ar * s_i + ai * s_r + bi; s_r = nr; s_i = ni; }
                Fre[nt] = s_r; Fim[nt] = s_i;
            }
            { const f32x4 w0 = {Fre[0], Fim[0], Fre[1], Fim[1]};
              *(LAS f32x4*)(EX + (fq * 16 + fr) * 16) = w0; }
            LDS_WAIT();
            float cinr[2], cini[2];
            { float Cr[2], Ci[2];
#pragma unroll
              for (int nt = 0; nt < 2; ++nt) { Cr[nt] = cyr[nt]; Ci[nt] = cyi[nt]; cinr[nt] = Cr[nt]; cini[nt] = Ci[nt]; }
#pragma unroll
              for (int q = 0; q < 4; ++q) { const f32x4 g0 = *(const LAS f32x4*)(EX + (q * 16 + fr) * 16);
                  const float Fr[2] = {g0.x, g0.z}, Fi[2] = {g0.y, g0.w};
#pragma unroll
                  for (int nt = 0; nt < 2; ++nt) { const float nCr = a16r[nt] * Cr[nt] - a16i[nt] * Ci[nt] + Fr[nt], nCi = a16r[nt] * Ci[nt] + a16i[nt] * Cr[nt] + Fi[nt]; Cr[nt] = nCr; Ci[nt] = nCi;
                      if (fq == q + 1) { cinr[nt] = nCr; cini[nt] = nCi; } } }
#pragma unroll
              for (int nt = 0; nt < 2; ++nt) { cyr[nt] = Cr[nt]; cyi[nt] = Ci[nt]; } }
            LDS_WAIT();
            asm volatile("" : "+v"(Xu[0]), "+v"(Xu[1]), "+v"(Xu[2]), "+v"(Xu[3]));
#pragma unroll
            for (int nt = 0; nt < 2; ++nt) {
                const float ar = are[nt], ai = aim[nt];
                f32x4 bu[4][2];
#pragma unroll
                for (int mt = 0; mt < 4; ++mt)
#pragma unroll
                    for (int ri = 0; ri < 2; ++ri) bu[mt][ri] = MFMA16(Xu[mt], Ybb[nt][ri], ((f32x4){0.f, 0.f, 0.f, 0.f}));
                float s_r = cinr[nt], s_i = cini[nt];
#pragma unroll
                for (int tt = 0; tt < 16; ++tt) { const float br = bu[tt >> 2][0][tt & 3], bi = bu[tt >> 2][1][tt & 3];
                    const float nr = ar * s_r - ai * s_i + br, ni = ar * s_i + ai * s_r + bi; s_r = nr; s_i = ni;
                    *(LAS unsigned*)(PB + (16 * fq + tt) * 272 + fr * 16 + (2 * half + nt) * 4) = pk2(nr, ni); }
            }
            LDS_WAIT(); __builtin_amdgcn_s_barrier(); asm volatile("" ::: "memory");
#pragma unroll
            for (int m2 = 0; m2 < 2; ++m2) { f32x4 y = {0.f, 0.f, 0.f, 0.f};
#pragma unroll
              for (int ks = 0; ks < 4; ++ks) { const bf16x8 Xs = *(const LAS bf16x8*)(PB + (32 * half + 16 * m2 + fr) * 272 + ks * 64 + fq * 16); y = MFMA16(Xs, Yc[ks], y); }
              if (dskip) y = MFMA16(Xn[m2], Ydg, y);
#pragma unroll
              for (int r = 0; r < 4; ++r) *(LAS bf16_t*)(YB + (16 * m2 + 4 * fq + r) * 32 + fr * 2) = f2bf(y[r]); }
            LDS_WAIT();
            { const u32x4 yv = *(const LAS u32x4*)(YB + lane * 16);
              *(u32x4*)(Yd + (size_t)__builtin_amdgcn_readfirstlane(s5_row(b, dir, n0)) * 512 + offY) = yv; }
            LDS_WAIT();
        }
#undef S5_PREFETCH
    }
}
#ifndef NSUBREP
#define NSUBREP 1
#endif
#ifndef NS12REP
#define NS12REP 1
#endif
constexpr int RS = 144, L_KB = 0, L_KN = 9216, L_QN = 18432, L_KE = 27648, L_QD = 36864, L_KDT = 46080, L_ST = 55296, L_RT = 64512, L_VB = 73728,
              L_RAW = 91136, L_LF = 91136, L_LB = 108544, L_T11T = 113152, L_MT = 117760, L_AT = 122368, L_CW = 131584, L_GC = 135424, L_TB = L_KB, L_VNT = L_QN;
__device__ __forceinline__ f32x4 tile_mma(const LAS unsigned char* X, int xr0, const LAS unsigned char* Y, int yr0, int fr, int fq, f32x4 acc) {
#pragma unroll
    for (int ks = 0; ks < 2; ++ks) {
        const bf16x8 xa = *(const LAS bf16x8*)(X + (xr0 + fr) * RS + ks * 64 + fq * 16);
        const bf16x8 yb = *(const LAS bf16x8*)(Y + (yr0 + fr) * RS + ks * 64 + fq * 16);
        acc = MFMA16(xa, yb, acc);
    }
    return acc;
}
__device__ __forceinline__ int gdn_row(int b, bool isctx, int s) { return isctx ? (ML + b * CTXL + s) : (b * SEQ + (s & 31) * 64 + (s >> 5)); }

#define GBAR() do { asm volatile("s_waitcnt lgkmcnt(0)" ::: "memory"); __builtin_amdgcn_s_barrier(); asm volatile("" ::: "memory"); } while (0)
__device__ __forceinline__ f32x4 tile_mma1(const LAS unsigned char* X, int xoff, const LAS unsigned char* Y, int yoff, f32x4 acc) {
    const bf16x8 xa = *(const LAS bf16x8*)(X + xoff); const bf16x8 yb = *(const LAS bf16x8*)(Y + yoff); return MFMA16(xa, yb, acc);
}
__device__ __forceinline__ void phase_gdn(const Args& a, int l, LAS unsigned char* lds, const bf16_t* QKV, const float* AB, bf16_t* O0, bf16_t* O1) {
    const int tid = opaque_tid(), lane = tid & 63, wave = __builtin_amdgcn_readfirstlane(tid >> 6), fr = lane & 15, fq = lane >> 4;
    LAS float* CW = (LAS float*)(lds + L_CW); LAS float* GC0 = (LAS float*)(lds + L_GC);
    LAS float* VB = (LAS float*)(lds + L_VB); LAS float* LF = (LAS float*)(lds + L_LF);
    for (int task = blockIdx.x; task < 256; task += gridDim.x) {
        const int b = task >> 4, h = (task >> 1) & 7, dir = task & 1;
        bf16_t* Od = dir ? O1 : O0;
        __syncthreads();
        for (int i = tid; i < 5 * 192; i += NT) { const int j = i / 192, ch = i % 192, sel = ch >> 6, cc = ch & 63; CW[i] = INP(21)[(size_t)(l * 5 + j) * 1536 + sel * 512 + 64 * h + cc]; }
        for (int i = tid; i < 64 * RS / 4; i += NT) ((LAS unsigned*)(lds + L_ST))[i] = 0u;
        const float alog = -expf(INP(22)[(l * 2 + dir) * 8 + h]), dtb = INP(23)[(l * 2 + dir) * 8 + h];
        f32x4 Sreg[2] = {{0.f, 0.f, 0.f, 0.f}, {0.f, 0.f, 0.f, 0.f}};
        u32x4 pre[4]; float pa = 0.f, pb = 0.f;
#define GDN_PREFETCH(CC) do { const bool ic_ = (CC) < 4; const int Lq_ = ic_ ? CTXL : SEQ, c_ = ic_ ? (CC) : (CC) - 4; const int sl_ = dir ? (Lq_ - 64 * (c_ + 1)) : 64 * c_; \
            _Pragma("unroll") for (int q_ = 0; q_ < 4; ++q_) { const int it_ = tid + q_ * NT; pre[q_] = (u32x4){0u, 0u, 0u, 0u}; \
                if (it_ < 68 * 24) { const int rr_ = it_ / 24, v_ = it_ % 24, sel_ = v_ >> 3, c8_ = v_ & 7, s_ = sl_ - 2 + rr_; \
                    if (s_ >= 0 && s_ < Lq_) pre[q_] = *(const u32x4*)(QKV + (size_t)gdn_row(b, ic_, s_) * 1536 + sel_ * 512 + 64 * h + 8 * c8_); } } \
            if (wave == 7) { const int s_ = dir ? (sl_ + 63 - lane) : (sl_ + lane); const size_t ro_ = (size_t)gdn_row(b, ic_, s_) * 32; pa = AB[ro_ + dir * 8 + h]; pb = AB[ro_ + 16 + dir * 8 + h]; } } while (0)
#define GDN_GATES(CN) do { LAS float* Gn_ = GC0 + ((CN) & 1) * 256; const float av_ = pa + dtb; const float sp_ = av_ > 20.f ? av_ : log1pf(expf(av_)); float gc_ = alog * sp_; \
            _Pragma("unroll") for (int o_ = 1; o_ < 64; o_ <<= 1) { const float t_ = __shfl_up(gc_, o_); if (lane >= o_) gc_ += t_; } \
            const float g63_ = __shfl(gc_, 63); Gn_[lane] = gc_; Gn_[64 + lane] = sigmoidf_(pb); Gn_[128 + lane] = expf(gc_); Gn_[192 + lane] = expf(g63_ - gc_); } while (0)
#define GDN_STAGE(CN) do { \
            _Pragma("unroll") for (int q_ = 0; q_ < 4; ++q_) { const int it_ = tid + q_ * NT; if (it_ < 68 * 24) *(LAS u32x4*)(lds + L_RAW + (it_ / 24) * 384 + (it_ % 24) * 16) = pre[q_]; } \
            if ((CN) + 1 < 36) GDN_PREFETCH((CN) + 1); } while (0)
        GDN_PREFETCH(0);
        if (wave == 7) GDN_GATES(0);
        GDN_STAGE(0);
        GBAR();
        for (int cc = 0; cc < 36; ++cc) {
            const bool isctx = cc < 4; const int Lq = isctx ? CTXL : SEQ, c = isctx ? cc : cc - 4;
            const int s_lo = dir ? (Lq - 64 * (c + 1)) : 64 * c;
            LAS float* GC = GC0 + (cc & 1) * 256; LAS float* BT = GC + 64; LAS float* EG = GC + 128; LAS float* EKD = GC + 192;
#pragma unroll
            for (int x2 = 0; x2 < 2; ++x2) { const int td = 2 * (wave >> 2) + x2, te = wave & 3; u32x2 o; o.x = pk2(Sreg[x2][0], Sreg[x2][1]); o.y = pk2(Sreg[x2][2], Sreg[x2][3]);
                *(LAS u32x2*)(lds + L_ST + (16 * te + fr) * RS + (16 * td + 4 * fq) * 2) = o; }
            for (int itc = 0; itc < 3; ++itc) {
                const int it = tid + itc * NT, v8 = it & 7, ps = it >> 3, i = ps / 3, sel = ps - 3 * i, ch0 = sel * 64 + v8 * 8;
                const int rc = (dir ? (63 - i) : i) + 2;
                float acc[8];
#pragma unroll
                for (int k = 0; k < 8; ++k) acc[k] = 0.f;
#pragma unroll
                for (int j = 0; j < 5; ++j) { const u32x4 x = *(const LAS u32x4*)(lds + L_RAW + (rc + j - 2) * 384 + ch0 * 2);
                    const f32x4 w0 = *(const LAS f32x4*)(CW + j * 192 + ch0), w1 = *(const LAS f32x4*)(CW + j * 192 + ch0 + 4);
                    acc[0] += w0.x * bflo(x.x); acc[1] += w0.y * bfhi(x.x); acc[2] += w0.z * bflo(x.y); acc[3] += w0.w * bfhi(x.y);
                    acc[4] += w1.x * bflo(x.z); acc[5] += w1.y * bfhi(x.z); acc[6] += w1.z * bflo(x.w); acc[7] += w1.w * bfhi(x.w); }
                float ss = 0.f;
#pragma unroll
                for (int k = 0; k < 8; ++k) { acc[k] = siluf_(acc[k]); ss += acc[k] * acc[k]; }
                ss += __shfl_xor(ss, 1); ss += __shfl_xor(ss, 2); ss += __shfl_xor(ss, 4);
                const float rn = rsqrtf(ss + EPS);
                const float bt = BT[i], eg = EG[i], ekd = EKD[i];
                if (sel == 0) {
                    const float s0 = rn * 0.125f, s1 = s0 * eg; u32x4 w0, w1;
                    w0.x = pk2(acc[0] * s0, acc[1] * s0); w0.y = pk2(acc[2] * s0, acc[3] * s0); w0.z = pk2(acc[4] * s0, acc[5] * s0); w0.w = pk2(acc[6] * s0, acc[7] * s0);
                    w1.x = pk2(acc[0] * s1, acc[1] * s1); w1.y = pk2(acc[2] * s1, acc[3] * s1); w1.z = pk2(acc[4] * s1, acc[5] * s1); w1.w = pk2(acc[6] * s1, acc[7] * s1);
                    *(LAS u32x4*)(lds + L_QN + i * RS + v8 * 16) = w0; *(LAS u32x4*)(lds + L_QD + i * RS + v8 * 16) = w1;
                } else if (sel == 1) {
                    const float s0 = rn, s1 = rn * bt, s2 = rn * eg, s3 = rn * ekd; u32x4 w0, w1, w2;
                    w0.x = pk2(acc[0] * s0, acc[1] * s0); w0.y = pk2(acc[2] * s0, acc[3] * s0); w0.z = pk2(acc[4] * s0, acc[5] * s0); w0.w = pk2(acc[6] * s0, acc[7] * s0);
                    w1.x = pk2(acc[0] * s1, acc[1] * s1); w1.y = pk2(acc[2] * s1, acc[3] * s1); w1.z = pk2(acc[4] * s1, acc[5] * s1); w1.w = pk2(acc[6] * s1, acc[7] * s1);
                    w2.x = pk2(acc[0] * s2, acc[1] * s2); w2.y = pk2(acc[2] * s2, acc[3] * s2); w2.z = pk2(acc[4] * s2, acc[5] * s2); w2.w = pk2(acc[6] * s2, acc[7] * s2);
                    *(LAS u32x4*)(lds + L_KN + i * RS + v8 * 16) = w0; *(LAS u32x4*)(lds + L_KB + i * RS + v8 * 16) = w1; *(LAS u32x4*)(lds + L_KE + i * RS + v8 * 16) = w2;
#pragma unroll
                    for (int k = 0; k < 8; ++k) *(LAS bf16_t*)(lds + L_KDT + (v8 * 8 + k) * RS + i * 2) = f2bf(acc[k] * s3);
                } else {
                    f32x4 w0 = {acc[0] * bt, acc[1] * bt, acc[2] * bt, acc[3] * bt}, w1 = {acc[4] * bt, acc[5] * bt, acc[6] * bt, acc[7] * bt};
                    *(LAS f32x4*)(VB + i * 68 + v8 * 8) = w0; *(LAS f32x4*)(VB + i * 68 + v8 * 8 + 4) = w1;
                }
            }
            GBAR();
            for (int q = wave; q < 10; q += 8) {
                const int ti = q < 1 ? 0 : q < 3 ? 1 : q < 6 ? 2 : 3; const int tj = q - (ti * (ti + 1)) / 2;
                const f32x4 w = tile_mma(lds + L_KB, 16 * ti, lds + L_KN, 16 * tj, fr, fq, (f32x4){0.f, 0.f, 0.f, 0.f});
                const int j = 16 * tj + fr; const float gj = GC[j];
#pragma unroll
                for (int r = 0; r < 4; ++r) { const int i = 16 * ti + 4 * fq + r; const float v = (i > j) ? w[r] * __expf(GC[i] - gj) : 0.f; LF[i * 68 + j] = v;
                    if (ti >= 2 && tj < 2) *(LAS bf16_t*)(lds + L_LB + (i - 32) * RS + j * 2) = f2bf(v); }
            }
            GBAR();
            if (wave == 0) {
                __builtin_amdgcn_s_setprio(3);
                int ln = lane; asm volatile("" : "+v"(ln));
                const int hb = ln >> 5, cl = ln & 31;
                const LAS float* Lb = LF + (32 * hb) * 68 + 32 * hb;
                float x[32];
                f32x4 Lr[2][8];
                Lr[1][0] = *(const LAS f32x4*)(Lb + 1 * 68);
#pragma unroll
                for (int i = 0; i < 32; ++i) {
                    asm volatile("" ::: "memory");
                    if (i >= 1 && i + 1 < 32) {
#pragma unroll
                        for (int v = 0; v < (i + 1 + 3) / 4; ++v) Lr[(i + 1) & 1][v] = *(const LAS f32x4*)(Lb + (i + 1) * 68 + 4 * v);
                    }
                    float a0 = (float)(1u - __builtin_elementwise_min((unsigned)(i ^ cl), 1u)), a1 = 0.f, a2 = 0.f, a3 = 0.f;
#pragma unroll
                    for (int v = 0; v < (i + 3) / 4; ++v) { const f32x4 lv = Lr[i & 1][v];
                        if (4 * v + 0 < i) a0 -= lv.x * x[4 * v + 0];
                        if (4 * v + 1 < i) a1 -= lv.y * x[4 * v + 1];
                        if (4 * v + 2 < i) a2 -= lv.z * x[4 * v + 2];
                        if (4 * v + 3 < i) a3 -= lv.w * x[4 * v + 3]; }
                    x[i] = (a0 + a1) + (a2 + a3);
                    *(LAS bf16_t*)(lds + L_TB + (32 * hb + i) * RS + (32 * hb + cl) * 2) = f2bf(x[i]);
                }
                if (hb == 0) {
#pragma unroll
                    for (int v = 0; v < 4; ++v) { u32x4 w; w.x = pk2(x[8 * v], x[8 * v + 1]); w.y = pk2(x[8 * v + 2], x[8 * v + 3]); w.z = pk2(x[8 * v + 4], x[8 * v + 5]); w.w = pk2(x[8 * v + 6], x[8 * v + 7]);
                        *(LAS u32x4*)(lds + L_T11T + cl * RS + v * 16) = w; }
                }
                LDS_WAIT();
#pragma unroll
                for (int t = 0; t < 4; ++t) { const int it = t >> 1, ct = t & 1;
                    const f32x4 m = tile_mma1(lds + L_LB, (16 * it + fr) * RS + fq * 16, lds + L_T11T, (16 * ct + fr) * RS + fq * 16, (f32x4){0.f, 0.f, 0.f, 0.f});
                    u32x2 o; o.x = pk2(m[0], m[1]); o.y = pk2(m[2], m[3]);
                    *(LAS u32x2*)(lds + L_MT + (16 * ct + fr) * RS + (16 * it + 4 * fq) * 2) = o; }
                LDS_WAIT();
#pragma unroll
                for (int t = 0; t < 4; ++t) { const int it = t >> 1, ct = t & 1;
                    const f32x4 m = tile_mma1(lds + L_TB, (32 + 16 * it + fr) * RS + 64 + fq * 16, lds + L_MT, (16 * ct + fr) * RS + fq * 16, (f32x4){0.f, 0.f, 0.f, 0.f});
#pragma unroll
                    for (int r = 0; r < 4; ++r) *(LAS bf16_t*)(lds + L_TB + (32 + 16 * it + 4 * fq + r) * RS + (16 * ct + fr) * 2) = f2bf(-m[r]); }
                __builtin_amdgcn_s_setprio(0);
            } else {
                const int ord = wave <= 3 ? wave - 1 : (wave == 6 ? 3 : (wave == 7 ? 6 : wave));
                for (int idx = ord; idx < 32; idx += 7) {
                    if (idx < 16) {
                        const int ti = idx >> 2, te = idx & 3;
                        const f32x4 w = tile_mma(lds + L_KE, 16 * ti, lds + L_ST, 16 * te, fr, fq, (f32x4){0.f, 0.f, 0.f, 0.f});
                        float rv[4];
#pragma unroll
                        for (int r = 0; r < 4; ++r) { const int i = 16 * ti + 4 * fq + r; rv[r] = VB[i * 68 + 16 * te + fr] - BT[i] * w[r]; }
                        u32x2 o; o.x = pk2(rv[0], rv[1]); o.y = pk2(rv[2], rv[3]);
                        *(LAS u32x2*)(lds + L_RT + (16 * te + fr) * RS + (16 * ti + 4 * fq) * 2) = o;
                    } else {
                        const int ti = (idx - 16) >> 2, tj = (idx - 16) & 3;
                        f32x4 w = {0.f, 0.f, 0.f, 0.f};
                        if (tj <= ti) w = tile_mma(lds + L_QN, 16 * ti, lds + L_KN, 16 * tj, fr, fq, w);
                        const int j = 16 * tj + fr; const float gj = GC[j];
#pragma unroll
                        for (int r = 0; r < 4; ++r) { const int i = 16 * ti + 4 * fq + r; const float v = (i >= j) ? w[r] * __expf(GC[i] - gj) : 0.f; *(LAS bf16_t*)(lds + L_AT + i * RS + j * 2) = f2bf(v); }
                    }
                }
                if (wave == 7 && cc + 1 < 36) GDN_GATES(cc + 1);
            }
            GBAR();
            {
                const int te = wave & 3, hb2 = wave >> 2;
#pragma unroll
                for (int ti = 0; ti < 4; ++ti) {
                    f32x4 w = tile_mma1(lds + L_TB, (16 * ti + fr) * RS + fq * 16, lds + L_RT, (16 * te + fr) * RS + fq * 16, (f32x4){0.f, 0.f, 0.f, 0.f});
                    if (ti >= 2) w = tile_mma1(lds + L_TB, (16 * ti + fr) * RS + 64 + fq * 16, lds + L_RT, (16 * te + fr) * RS + 64 + fq * 16, w);
                    u32x2 o; o.x = pk2(w[0], w[1]); o.y = pk2(w[2], w[3]);
                    *(LAS u32x2*)(lds + L_VNT + (16 * te + fr) * RS + (16 * ti + 4 * fq) * 2) = o; }
                LDS_WAIT();
                const float gl = EG[63];
#pragma unroll
                for (int x2 = 0; x2 < 2; ++x2) { const int ti = 2 * hb2 + x2;
                    const f32x4 p1 = tile_mma(lds + L_QD, 16 * ti, lds + L_ST, 16 * te, fr, fq, (f32x4){0.f, 0.f, 0.f, 0.f});
                    const f32x4 o = tile_mma(lds + L_AT, 16 * ti, lds + L_VNT, 16 * te, fr, fq, p1);
#pragma unroll
                    for (int r = 0; r < 4; ++r) { const int i = 16 * ti + 4 * fq + r; const int s = dir ? (s_lo + 63 - i) : (s_lo + i);
                        Od[(size_t)gdn_row(b, isctx, s) * 512 + 64 * h + 16 * te + fr] = f2bf(o[r]); }
                    Sreg[x2] = tile_mma(lds + L_KDT, 16 * ti, lds + L_VNT, 16 * te, fr, fq, Sreg[x2] * gl); }
            }
            if (cc + 1 < 36) GDN_STAGE(cc + 1);
            GBAR();
        }
#undef GDN_STAGE
#undef GDN_GATES
#undef GDN_PREFETCH
    }
}
#ifndef GALIGN
#define GALIGN true
#endif
#ifndef GSP2
#define GSP2 true
#endif

#define XB_TMO      128
#define XB_XCNT(j)  (256  + 64 * (j))
#define XB_XSUB(j)  (1280 + 64 * (j))
#define XB_XGEN(j)  (2304 + 64 * (j))
#define XB_TOP      3328
#define XB_TOPGEN   3392
#define XCD_BAR_WORDS 3456
#define XB_SPIN_CAP (1u << 18)
__device__ __forceinline__ unsigned xb_ld(unsigned* p)              { return __hip_atomic_load(p, __ATOMIC_RELAXED, __HIP_MEMORY_SCOPE_AGENT); }
__device__ __forceinline__ unsigned xb_add(unsigned* p, unsigned v) { return __hip_atomic_fetch_add(p, v, __ATOMIC_RELAXED, __HIP_MEMORY_SCOPE_AGENT); }
__device__ __forceinline__ unsigned xb_xcc_id() { return (unsigned)__builtin_amdgcn_s_getreg((3 << 11) | 20) & 0xFu; }
#define XB_SPIN(cond, bar) do { unsigned _sp = 0; while (cond) { __builtin_amdgcn_s_sleep(1); \
    if ((++_sp & 255u) == 0u) { if (xb_ld(&(bar)[XB_TMO])) break; if (_sp > XB_SPIN_CAP) { atomicAdd(&(bar)[XB_TMO], 1u); break; } } } } while (0)

struct XcdBarrier {
    unsigned* bar; unsigned x;
    volatile LAS unsigned* st;
};

__device__ __forceinline__ XcdBarrier xcd_barrier_post(unsigned* bar, volatile LAS unsigned* st) {
    XcdBarrier b; b.bar = bar; b.x = xb_xcc_id(); b.st = st;
    if (threadIdx.x == 0) (void)xb_add(&bar[XB_XCNT(b.x)], 1u);
    return b;
}
__device__ __forceinline__ void xcd_barrier_complete(unsigned* bar, unsigned x, unsigned& nloc, unsigned& nx) {
    const unsigned G = gridDim.x * gridDim.y * gridDim.z;
    unsigned sum, cnt, mine, sp = 0u;
    for (;;) {
        sum = 0u; cnt = 0u; mine = 0u;
#pragma unroll
        for (unsigned j = 0; j < 16; ++j) { const unsigned c = xb_ld(&bar[XB_XCNT(j)]); sum += c; cnt += (c > 0u) ? 1u : 0u; mine = (j == x) ? c : mine; }
        if (sum == G) break;
        __builtin_amdgcn_s_sleep(1);
        if ((++sp & 255u) == 0u) { if (xb_ld(&bar[XB_TMO])) break; if (sp > XB_SPIN_CAP) { atomicAdd(&bar[XB_TMO], 1u); break; } }
    }
    nloc = mine > 0u ? mine : 1u; nx = cnt > 0u ? cnt : 1u;
}

__device__ __forceinline__ void xcd_barrier(const XcdBarrier& b) {
    asm volatile("s_waitcnt vmcnt(0)" ::: "memory");
    __syncthreads();
    if (threadIdx.x == 0) {
        unsigned* bar = b.bar;
        __builtin_amdgcn_s_waitcnt(0);
        unsigned nloc = b.st[0], nx = b.st[1];
        if (nloc == 0u) { xcd_barrier_complete(bar, b.x, nloc, nx); b.st[0] = nloc; b.st[1] = nx; }
        const unsigned old = xb_add(&bar[XB_XSUB(b.x)], 1u);
        const unsigned gen = old / nloc;
        if (old + 1u == (gen + 1u) * nloc) {
            __builtin_amdgcn_fence(__ATOMIC_RELEASE, "agent");
            asm volatile("s_waitcnt vmcnt(0)" ::: "memory");
            const unsigned og = xb_add(&bar[XB_TOP], 1u);
            const unsigned tg = og / nx;
            if (og + 1u == (tg + 1u) * nx) xb_add(&bar[XB_TOPGEN], 1u);
            else XB_SPIN(xb_ld(&bar[XB_TOPGEN]) == tg, bar);
            __builtin_amdgcn_fence(__ATOMIC_ACQUIRE, "agent");
            xb_add(&bar[XB_XGEN(b.x)], 1u);
            asm volatile("s_waitcnt vmcnt(0)" ::: "memory");
        } else {
            XB_SPIN(xb_ld(&bar[XB_XGEN(b.x)]) == gen, bar);
            __builtin_amdgcn_fence(__ATOMIC_ACQUIRE, "agent");
            asm volatile("s_waitcnt vmcnt(0)" ::: "memory");
        }
    }
    __syncthreads();
}


template <class Epi>
__device__ __forceinline__ void run_gemm_sub(LAS unsigned char* lds, const bf16_t* A, const bf16_t* Bt, int M, int N, int K, const Epi& E, int G, int c) {
    const int oz = opaque_zero(); M += oz; N += oz; K += oz;
    pg8::Gemm g{A, Bt, M, N, K}; pg8::StaticOrder S; S.init(M, N, G, c);
    pg8::gemm_phase<Epi, pg8::StaticOrder, GALIGN, GSP2>(lds, g, S, E);
    __syncthreads();
}
template <class Epi>
__device__ __forceinline__ void run_gemm(LAS unsigned char* lds, const bf16_t* A, const bf16_t* Bt, int M, int N, int K, const Epi& E) {
    const int oz = opaque_zero(); M += oz; N += oz; K += oz;
    pg8::Gemm g{A, Bt, M, N, K}; pg8::StaticOrder S; S.init(M, N, (int)gridDim.x, (int)blockIdx.x);
#ifndef NO_GEMM
    pg8::gemm_phase<Epi, pg8::StaticOrder, GALIGN, GSP2>(lds, g, S, E);
#endif
    __syncthreads();
}


#ifdef DBG
__device__ __forceinline__ void dbg16(const bf16_t* p, size_t n, unsigned* flags) {
    unsigned bad = 0; const int tid = opaque_tid();
    for (size_t i = (size_t)blockIdx.x * NT + tid; i < n / 2; i += (size_t)gridDim.x * NT) { const unsigned v = ((const unsigned*)p)[i]; bad += ((v & 0x7F80u) == 0x7F80u) + ((v & 0x7F800000u) == 0x7F800000u); }
    if (bad) atomicAdd(flags, bad);
}
__device__ __forceinline__ void dbg32(const float* p, size_t n, unsigned* flags) {
    unsigned bad = 0; const int tid = opaque_tid();
    for (size_t i = (size_t)blockIdx.x * NT + tid; i < n; i += (size_t)gridDim.x * NT) { const unsigned v = ((const unsigned*)p)[i]; bad += ((v & 0x7F800000u) == 0x7F800000u); }
    if (bad) atomicAdd(flags, bad);
}
#define FLG ((unsigned*)(WSO(WS_MOD) + 1536 * 1024))
#define D16(p, n, bit) do { if (DBG == (bit) && l == 0) { grid.sync(); dbg16((p), (size_t)(n), FLG); } } while (0)
#define D32(p, n, bit) do { if (DBG == (bit) && l == 0) { grid.sync(); dbg32((p), (size_t)(n), FLG); } } while (0)
#define DSTOP(bit) do { if (DBG == (bit) && l == 0) goto dbg_end; } while (0)
#else
#define D16(p, n, bit) do {} while (0)
#define D32(p, n, bit) do {} while (0)
#define DSTOP(bit) do {} while (0)
#endif
#ifdef USE_CG_SYNC
#define GSYNC() grid.sync()
#else
#define GSYNC() do { XcdBarrier xb_; xb_.bar = (unsigned*)(WSO(WS_MOD) + 1792 * 1024); xb_.x = xb_xcc_id(); xb_.st = (volatile LAS unsigned*)(lds + LDS_BYTES - 16); xcd_barrier(xb_); } while (0)
#endif
__global__ void __launch_bounds__(NT, 2) mega_fwd(Args a) {
    extern __shared__ __attribute__((aligned(16))) unsigned char lds_raw[];
    LAS unsigned char* lds = (LAS unsigned char*)lds_raw;
    cg::grid_group grid = cg::this_grid();
    volatile LAS unsigned* xst = (volatile LAS unsigned*)(lds + LDS_BYTES - 16);
    if (threadIdx.x < 4) xst[threadIdx.x] = 0u;
    __syncthreads();
    (void)xcd_barrier_post((unsigned*)(WSO(WS_MOD) + 1792 * 1024), xst);
#define P_(T, off) ((T*)WSO(off))
#define MOD P_(float, WS_MOD)
#define hc P_(float, WS_HC)
#define XN P_(bf16_t, WS_XN)
#define HID P_(bf16_t, WS_HID)
#define U P_(bf16_t, WS_U)
#define QKV P_(bf16_t, WS_QKV)
#define Z P_(bf16_t, WS_Z)
#define G P_(bf16_t, WS_G)
#define AB P_(float, WS_AB)
#define YAP P_(bf16_t, WS_YAP)
#define O0 P_(bf16_t, WS_O0)
#define O1 P_(bf16_t, WS_O1)
#define Y1 P_(bf16_t, WS_FREE)
#define YA P_(bf16_t, WS_FREE)
#define MRG P_(bf16_t, WS_MRG)
#define W1A P_(const bf16_t, WS_W1A)
#define W1B P_(const bf16_t, WS_W1B)
#define WIN P_(const bf16_t, WS_WIN)
#define WGLU P_(const bf16_t, WS_WGLU)
#define WPA P_(const bf16_t, WS_WPA)
#define WPB P_(const bf16_t, WS_WPB)
#define WO P_(const bf16_t, WS_WO)
#define W2A P_(const bf16_t, WS_W2A)
#define W2B P_(const bf16_t, WS_W2B)
#define h ((float*)KARG(32))
#ifndef NO_MOD
    phase_mod(a, lds, MOD);
#endif
    phase_convert_part(a, 0, lds, 0, (int)blockIdx.x, (int)gridDim.x);
    phase_convert_part(a, 0, lds, 1, (int)blockIdx.x, (int)gridDim.x);
    grid.sync();
    for (int l = 0; l < DEPTH; ++l) {
        const bool last = (l == DEPTH - 1);
        #define modl (MOD + (size_t)l * 17 * 9216)
        #define src_lat (l == 0 ? INP(0) : h)
#define src_ctx (l == 0 ? INP(2) : hc)
        const int M2 = last ? ML : MALL;
        if (l > 0) phase_convert_part(a, l, lds, 1, (int)blockIdx.x, (int)gridDim.x);
        phase_norm(src_lat, src_ctx, INP(6) + l * D, modl, 0, 1, XN, MALL);
        D32(MOD, 2 * 17 * 9216, 0); D16(W1A, 24 * MiB, 1); D16(XN, (size_t)MALL * D, 2);
        DSTOP(0); DSTOP(1); DSTOP(2);
        GSYNC();
        run_gemm(lds, XN, W1A, MALL, 2 * DFF, D, EpiSwiGLU{HID});
#ifdef REP_UP
        GSYNC();
        run_gemm(lds, XN, W1A, MALL, 2 * DFF, D, EpiSwiGLU{HID});
#endif
        D16(HID, (size_t)MALL * DFF, 3);
        DSTOP(3);
        GSYNC();
#ifndef NO_TAIL
        run_gemm(lds, HID, W1B, ML, D, DFF, EpiResid{src_lat, src_ctx, h, hc, modl + 2 * 1024, 0.5f});
        GSYNC();
        if (blockIdx.x < 64) run_gemm_sub(lds, HID + (size_t)ML * DFF, W1B, MC, D, DFF, EpiResid{src_lat, src_ctx, h, hc, modl + 2 * 1024, 0.5f, ML}, 64, (int)blockIdx.x);
        else phase_norm_range(h, hc, INP(9) + l * D, modl, 3, 4, XN, 0, ML, (int)blockIdx.x - 64, (int)gridDim.x - 64);
        GSYNC();
        phase_norm_range(h, hc, INP(9) + l * D, modl, 3, 4, XN, ML, MALL, (int)blockIdx.x, (int)gridDim.x);
        GSYNC();
#else
        run_gemm(lds, HID, W1B, MALL, D, DFF, EpiResid{src_lat, src_ctx, h, hc, modl + 2 * 1024, 0.5f});
        D32(h, (size_t)ML * D, 4); D32(hc, (size_t)MC * D, 4);
        DSTOP(4);
        GSYNC();
        phase_norm(h, hc, INP(9) + l * D, modl, 3, 4, XN, MALL);
#ifdef REP_NORM
        GSYNC();
        phase_norm(h, hc, INP(9) + l * D, modl, 3, 4, XN, MALL);
#endif
        D16(XN, (size_t)MALL * D, 5);
        DSTOP(5);
        GSYNC();
#endif
        run_gemm(lds, XN, WIN, MALL, NWIN, D, EpiWin{U, QKV, Z, G, AB});
#ifdef REP_WIN
        GSYNC();
        run_gemm(lds, XN, WIN, MALL, NWIN, D, EpiWin{U, QKV, Z, G, AB});
#endif
        D16(U, (size_t)MALL * 512, 6); D16(QKV, (size_t)MALL * 1536, 7); D16(Z, (size_t)MALL * 512, 8); D16(G, (size_t)MALL * 2048, 8); D32(AB, (size_t)MALL * 32, 9);
        DSTOP(6); DSTOP(7); DSTOP(8); DSTOP(9);
        GSYNC();
#ifndef NO_S5
        phase_s5(a, l, lds, U, YAP, Y1);
#ifdef REP_SYNC
        for (int rs = 0; rs < 10; ++rs) GSYNC();
#endif
#ifdef REP_S5
        GSYNC();
        phase_s5(a, l, lds, U, YAP, Y1);
#endif
#endif
        D16(YAP, (size_t)MALL * 512, 10); D16(Y1, (size_t)MALL * 512, 10); D16(O0, (size_t)MALL * 512, 26); D16(O1, (size_t)MALL * 512, 27);
        DSTOP(10); DSTOP(26); DSTOP(27);
        GSYNC();
        phase_s5_combine(YAP, Y1, MALL);
#ifndef NO_GDN
        phase_gdn(a, l, lds, QKV, AB, O0, O1);
#ifdef REP_GDN
        GSYNC();
        phase_gdn(a, l, lds, QKV, AB, O0, O1);
#endif
#endif
        D16(O0, (size_t)MALL * 512, 11); D16(O1, (size_t)MALL * 512, 11); D16(YAP, (size_t)MALL * 512, 12);
        D16(O0, (size_t)MALL * 512, 22); D16(O1, (size_t)MALL * 512, 23); D16(O0, (size_t)ML * 512, 24); D16(O1, (size_t)ML * 512, 25);
        DSTOP(11); DSTOP(12); DSTOP(20); DSTOP(21); DSTOP(22); DSTOP(23); DSTOP(24); DSTOP(25);
        GSYNC();
        if (last) phase_gdn_finish(O0, O1, Z, INP(24) + l * 64, M2, (int)blockIdx.x, (int)gridDim.x);
        else if (blockIdx.x >= 32) phase_gdn_finish(O0, O1, Z, INP(24) + l * 64, M2, (int)blockIdx.x - 32, (int)gridDim.x - 32);
        run_gemm(lds, YAP, WGLU, M2, 512, 512, EpiGLU{YAP, YA, INP(20) + l * 512});
        D16(O0, (size_t)M2 * 512, 13); D16(YA, (size_t)M2 * 512, 13);
        DSTOP(13);
        GSYNC();
        run_gemm(lds, YA, WPA, M2, D, 512, EpiMerge<0>{G, MRG});
        run_gemm(lds, O0, WPB, M2, D, 512, EpiMerge<1>{G, MRG});
        D16(MRG, (size_t)M2 * D, 14);
        DSTOP(14);
        GSYNC();
        run_gemm(lds, MRG, WO, M2, D, D, EpiResid{h, hc, h, hc, modl + 5 * 1024, 1.0f});
        if (!last && blockIdx.x >= 64) phase_convert_part(a, l + 1, lds, 0, (int)blockIdx.x - 64, (int)gridDim.x - 64);
        D32(h, (size_t)ML * D, 15);
        DSTOP(15);
        GSYNC();
        phase_norm(h, hc, INP(28) + l * D, modl, 6, 7, XN, M2);
        GSYNC();
        run_gemm(lds, XN, W2A, M2, 2 * DFF, D, EpiSwiGLU{HID});
        D16(HID, (size_t)M2 * DFF, 16);
        DSTOP(16);
        GSYNC();
        run_gemm(lds, HID, W2B, M2, D, DFF, EpiResid{h, hc, h, hc, modl + 8 * 1024, 0.5f});
        D32(h, (size_t)ML * D, 17);
        DSTOP(17);
        GSYNC();
    }
#ifdef DBG
    dbg_end:
    GSYNC();
    { float* o = h; const int tid = opaque_tid();
      for (size_t i = (size_t)blockIdx.x * NT + tid; i < (size_t)ML * D; i += (size_t)gridDim.x * NT) o[i] = 0.f;
      GSYNC();
      if (blockIdx.x == 0 && tid == 0) { const unsigned f = *FLG; int c = 0; if (f) c = (DBG == 20 || DBG == 21) ? (int)f : 32 - __clz((int)f); o[0] = 5792.6f * (float)c; } }
#else
    phase_final(h, INP(31));
#endif
}

extern "C" void kernel_launch(void* const* d_in, const int* in_sizes, int n_in, void* d_out, int out_size, void* d_ws, size_t ws_size, hipStream_t stream) {
    static int grid_blocks = 0;
    if (grid_blocks == 0) {
        if (n_in != 32 || ws_size < WS_END) { fprintf(stderr, "kernel_launch: unexpected inputs (n_in %d, ws %zu)\n", n_in, ws_size); grid_blocks = -1; return; }
        int dev = 0, cus = 0, per_cu = 0;
        hipGetDevice(&dev);
        hipDeviceGetAttribute(&cus, hipDeviceAttributeMultiprocessorCount, dev);
        if (hipFuncSetAttribute((const void*)mega_fwd, hipFuncAttributeMaxDynamicSharedMemorySize, LDS_BYTES) != hipSuccess) { fprintf(stderr, "kernel_launch: hipFuncSetAttribute failed\n"); grid_blocks = -1; return; }
        if (hipOccupancyMaxActiveBlocksPerMultiprocessor(&per_cu, (const void*)mega_fwd, NT, LDS_BYTES) != hipSuccess || per_cu < 1) { fprintf(stderr, "kernel_launch: occupancy query gave %d\n", per_cu); per_cu = 1; }
        (void)hipGetLastError();
        grid_blocks = cus * 1;
        if (cus != 256) { fprintf(stderr, "kernel_launch: built for a 256-CU device (got %d)\n", cus); grid_blocks = -1; return; }
    }
    if (grid_blocks < 0) return;
#ifdef DBG
    hipMemsetAsync((char*)d_ws + 1536 * 1024, 0, 256, stream);
#endif
    hipMemsetAsync((char*)d_ws + 1792 * 1024, 0, 16384, stream);
    Args a{};
    for (int i = 0; i < 32; ++i) a.in[i] = (const float*)d_in[i];
    a.in[32] = (const float*)d_out; a.in[33] = (const float*)d_ws;
    void* args[] = {&a};
    hipError_t e = hipLaunchCooperativeKernel((const void*)mega_fwd, dim3(grid_blocks), dim3(NT), args, LDS_BYTES, stream);
    if (e != hipSuccess) fprintf(stderr, "cooperative launch failed: %s (grid %d)\n", hipGetErrorString(e), grid_blocks);
}
```

```cpp
#include <hip/hip_runtime.h>
#include <hip/hip_cooperative_groups.h>
#include <cstdio>
#include <cstdint>
namespace cg = cooperative_groups;
namespace pg8 {
#define PG8_LAS __attribute__((address_space(3)))
typedef unsigned short bf16_t;
typedef short bf16x8 __attribute__((ext_vector_type(8)));
typedef float f32x4 __attribute__((ext_vector_type(4)));
typedef unsigned u32x4 __attribute__((ext_vector_type(4)));
constexpr int BM = 256, BK = 64, HALF = 128, HTB = HALF * BK * 2  , STAGE_BYTES = 8 * HTB, NXCD = 8, WGM = 8;

__host__ __device__ __forceinline__ int lds_byte(int r, int c) { const int st = (r >> 4) * 2 + (c >> 5), rr = r & 15, cc = c & 31, ob = rr * 64 + cc * 2; return st * 1024 + (ob ^ (((ob >> 9) & 1) << 5)); }
__host__ __device__ __forceinline__ void stage_rc(int b, int& R, int& C) { const int st = b / 1024, sb = b % 1024, swz = sb ^ (((sb >> 9) & 1) << 5); R = (st >> 1) * 16 + swz / 64; C = (st & 1) * 32 + (swz % 64) / 2; }
__host__ __device__ __forceinline__ int perm32(int rho) { const int n = rho >> 4, i = rho & 15; return 8 * (i >> 2) + 4 * n + (i & 3); }

struct Unit { int pm, pn; };
struct Gemm { const bf16_t* A; const bf16_t* Bt; int M, N, K; };

struct StaticOrder {
    int nM, nN, nwg, G, c;
    __host__ __device__ void init(int M, int N, int G_, int c_) { nM = M / BM; nN = N / BM; nwg = nM * nN; G = G_; c = c_; }
    __host__ __device__ bool next(int i, Unit& u) const {
        const long L = (long)i * G + c; if (L >= nwg) return false;
        int wgid = (int)L; { const int q = nwg / NXCD, r = nwg % NXCD, xcd = wgid % NXCD, off = wgid / NXCD; wgid = (xcd < r ? xcd * (q + 1) : r * (q + 1) + (xcd - r) * q) + off; }
        const int nig = WGM * nN, gid = wgid / nig, fm = gid * WGM, gsz = (nM - fm) < WGM ? (nM - fm) : WGM;
        u.pm = fm + ((wgid % nig) % gsz); u.pn = (wgid % nig) / gsz; return true;
    }
    __device__ __forceinline__ void a_ready(const Unit&) const {}
    __device__ __forceinline__ void done(const Unit&) const {}
};
__device__ __forceinline__ unsigned cvt_pk_bf16(float lo, float hi) { unsigned r; asm volatile("v_cvt_pk_bf16_f32 %0, %1, %2" : "=v"(r) : "v"(lo), "v"(hi)); return r; }
template <class Epi, class Sched, bool ALIGN_EPI = false, bool SP2 = false>
__device__ __forceinline__ void gemm_phase(PG8_LAS unsigned char* lds, const Gemm g, const Sched& S, const Epi& E) {
    int tid_ = threadIdx.x; asm volatile("" : "+v"(tid_)); const int tid = tid_, wid = __builtin_amdgcn_readfirstlane(tid >> 6), lane = tid & 63, wr = wid >> 2, wc = wid & 3, fr = lane & 15, fq = lane >> 4;
    const int K = g.K, nt = K / BK;
    unsigned voffA[2], voffB[2];
#pragma unroll
    for (int i = 0; i < 2; ++i) { int R, C; stage_rc(tid * 16 + i * 8192, R, C); const int Rb = Epi::PERM ? ((R & ~31) + perm32(R & 31)) : R;
        voffA[i] = (unsigned)(R * K + C) * 2u; voffB[i] = (unsigned)(Rb * K + C) * 2u; }
    const size_t kstep = (size_t)(BK * 2);
    const size_t hstep = (size_t)HALF * K * 2;
    const size_t tstep = 2 * hstep;
    const unsigned ldsw = (unsigned)wid * 1024u;
    const int aoff = lds_byte(wr * 64 + fr, fq * 8), boff = lds_byte(wc * 32 + fr, fq * 8);
#define PG8_SA(b, h) (((b) * 2 + (h)) * HTB)
#define PG8_SB(b, h) ((4 + (b) * 2 + (h)) * HTB)
#define PG8_STAGE(bufoff, gbase, voff) do { _Pragma("unroll") for (int _i = 0; _i < 2; ++_i) \
        __builtin_amdgcn_global_load_lds((const unsigned*)((const char*)(gbase) + (voff)[_i]), (PG8_LAS unsigned*)(lds + (bufoff) + ldsw + _i * 8192), 16, 0, 0); } while (0)
#define PG8_LDA(dst, b, h) do { _Pragma("unroll") for (int m = 0; m < 4; ++m) _Pragma("unroll") for (int k = 0; k < 2; ++k) dst[m][k] = *(const PG8_LAS bf16x8*)(lds + PG8_SA(b, h) + aoff + m * 2048 + k * 1024); } while (0)
#define PG8_LDB(dst, b, h) do { _Pragma("unroll") for (int n = 0; n < 2; ++n) _Pragma("unroll") for (int k = 0; k < 2; ++k) dst[n][k] = *(const PG8_LAS bf16x8*)(lds + PG8_SB(b, h) + boff + n * 2048 + k * 1024); } while (0)
#define PG8_MMA(ai, bj, At, Bt) do { __builtin_amdgcn_s_setprio(1); _Pragma("unroll") for (int m = 0; m < 4; ++m) _Pragma("unroll") for (int n = 0; n < 2; ++n) _Pragma("unroll") for (int k = 0; k < 2; ++k) \
        acc[ai][bj][m][n] = __builtin_amdgcn_mfma_f32_16x16x32_bf16(Bt[n][k], At[m][k], acc[ai][bj][m][n], 0, 0, 0); __builtin_amdgcn_s_setprio(0); } while (0)
#define PG8_WAIT_V(n) asm volatile("s_waitcnt vmcnt(" #n ")" ::: "memory")
#define PG8_WAIT_L(n) asm volatile("s_waitcnt lgkmcnt(" #n ")" ::: "memory")
#define PG8_BAR __builtin_amdgcn_s_barrier()
#define PG8_SCHED __builtin_amdgcn_sched_barrier(0)
    Unit cur, nxt; int ui = 0;
    if (!S.next(0, cur)) return;
    f32x4 acc[2][2][4][2];
#pragma unroll
    for (int a = 0; a < 2; ++a)
#pragma unroll
        for (int b = 0; b < 2; ++b)
#pragma unroll
            for (int m = 0; m < 4; ++m)
#pragma unroll
                for (int n = 0; n < 2; ++n) acc[a][b][m][n] = (f32x4){0.f, 0.f, 0.f, 0.f};
    bf16x8 At[4][2], B0[2][2], B1[2][2];
    const char* cA = (const char*)g.A + (size_t)cur.pm * tstep; const char* cB = (const char*)g.Bt + (size_t)cur.pn * tstep;
    S.a_ready(cur);
    if constexpr (SP2) {
        PG8_STAGE(PG8_SB(0, 0), cB, voffB); PG8_STAGE(PG8_SB(0, 1), cB + hstep, voffB); PG8_STAGE(PG8_SA(0, 0), cA, voffA); PG8_STAGE(PG8_SA(0, 1), cA + hstep, voffA);
        if (wr == 1) PG8_BAR;
        PG8_WAIT_V(2); PG8_BAR;
        PG8_STAGE(PG8_SB(1, 0), cB + kstep, voffB); PG8_STAGE(PG8_SA(1, 0), cA + kstep, voffA); PG8_STAGE(PG8_SB(1, 1), cB + hstep + kstep, voffB);
        PG8_WAIT_V(6); PG8_BAR;
    } else {
        PG8_STAGE(PG8_SB(0, 0), cB, voffB); PG8_STAGE(PG8_SA(0, 0), cA, voffA); PG8_STAGE(PG8_SB(0, 1), cB + hstep, voffB); PG8_STAGE(PG8_SA(0, 1), cA + hstep, voffA);
        if (wr == 1) PG8_BAR;
        PG8_WAIT_V(4); PG8_BAR;
        PG8_STAGE(PG8_SB(1, 0), cB + kstep, voffB); PG8_STAGE(PG8_SA(1, 0), cA + kstep, voffA); PG8_STAGE(PG8_SB(1, 1), cB + hstep + kstep, voffB);
        PG8_WAIT_V(6); PG8_BAR;
    }
    for (;;) {
        const bool has_next = S.next(ui + 1, nxt);
        const char* nA = has_next ? (const char*)g.A + (size_t)nxt.pm * tstep : cA; const char* nB = has_next ? (const char*)g.Bt + (size_t)nxt.pn * tstep : cB;
        for (int t = 0; t < nt; t += 2) {
            const bool last = (t == nt - 2);
            const char* a1 = cA + (size_t)(t + 1) * kstep;
            const char* a2 = last ? nA : cA + (size_t)(t + 2) * kstep; const char* b2 = last ? nB : cB + (size_t)(t + 2) * kstep;
            const char* a3 = a2 + kstep; const char* b3 = b2 + kstep;
            if (last && has_next) S.a_ready(nxt);
            if constexpr (SP2) {
            PG8_LDB(B0, 0, 0); PG8_LDB(B1, 0, 1); PG8_SCHED; PG8_LDA(At, 0, 0); PG8_STAGE(PG8_SA(1, 1), a1 + hstep, voffA);
            PG8_WAIT_V(8); PG8_WAIT_L(0); PG8_BAR; PG8_MMA(0, 0, At, B0); PG8_MMA(0, 1, At, B1); PG8_BAR; PG8_SCHED;
            PG8_LDA(At, 0, 1); PG8_STAGE(PG8_SB(0, 0), b2, voffB); PG8_STAGE(PG8_SB(0, 1), b2 + hstep, voffB); PG8_STAGE(PG8_SA(0, 0), a2, voffA);
            PG8_WAIT_V(8); PG8_WAIT_L(0); PG8_BAR; PG8_MMA(1, 0, At, B0); PG8_MMA(1, 1, At, B1); PG8_BAR; PG8_SCHED;
            PG8_LDB(B0, 1, 0); PG8_LDB(B1, 1, 1); PG8_SCHED; PG8_LDA(At, 1, 0); PG8_STAGE(PG8_SA(0, 1), a2 + hstep, voffA);
            PG8_WAIT_V(8); PG8_WAIT_L(0); PG8_BAR; PG8_MMA(0, 0, At, B0); PG8_MMA(0, 1, At, B1); PG8_BAR; PG8_SCHED;
            PG8_LDA(At, 1, 1); PG8_STAGE(PG8_SB(1, 0), b3, voffB); PG8_STAGE(PG8_SB(1, 1), b3 + hstep, voffB); PG8_STAGE(PG8_SA(1, 0), a3, voffA);
            PG8_WAIT_V(8); PG8_WAIT_L(0); PG8_BAR; PG8_MMA(1, 0, At, B0); PG8_MMA(1, 1, At, B1); PG8_BAR; PG8_SCHED;
            } else {
            PG8_LDB(B0, 0, 0); PG8_SCHED; PG8_LDA(At, 0, 0); PG8_STAGE(PG8_SA(1, 1), a1 + hstep, voffA);
            PG8_WAIT_L(8); PG8_BAR; PG8_WAIT_L(0); PG8_MMA(0, 0, At, B0); PG8_BAR; PG8_SCHED;
            PG8_LDB(B1, 0, 1); PG8_STAGE(PG8_SB(0, 0), b2, voffB);
            PG8_BAR; PG8_WAIT_L(0); PG8_MMA(0, 1, At, B1); PG8_BAR;
            PG8_LDA(At, 0, 1); PG8_STAGE(PG8_SA(0, 0), a2, voffA);
            PG8_BAR; PG8_WAIT_L(0); PG8_MMA(1, 0, At, B0); PG8_BAR; PG8_SCHED;
            PG8_STAGE(PG8_SB(0, 1), b2 + hstep, voffB);
            PG8_WAIT_V(6); PG8_BAR; PG8_MMA(1, 1, At, B1); PG8_BAR;
            PG8_LDB(B0, 1, 0); PG8_SCHED; PG8_LDA(At, 1, 0); PG8_STAGE(PG8_SA(0, 1), a2 + hstep, voffA);
            PG8_WAIT_L(8); PG8_BAR; PG8_WAIT_L(0); PG8_MMA(0, 0, At, B0); PG8_BAR; PG8_SCHED;
            PG8_LDB(B1, 1, 1); PG8_STAGE(PG8_SB(1, 0), b3, voffB);
            PG8_BAR; PG8_WAIT_L(0); PG8_MMA(0, 1, At, B1); PG8_BAR;
            PG8_LDA(At, 1, 1); PG8_STAGE(PG8_SA(1, 0), a3, voffA);
            PG8_BAR; PG8_WAIT_L(0); PG8_MMA(1, 0, At, B0); PG8_BAR; PG8_SCHED;
            PG8_STAGE(PG8_SB(1, 1), b3 + hstep, voffB);
            PG8_WAIT_V(6); PG8_BAR; PG8_MMA(1, 1, At, B1); PG8_BAR;
            }
        }
        if constexpr (ALIGN_EPI) { if (wr == 0) PG8_BAR; }
        if constexpr (!Epi::AFTER_DRAIN) { E(acc, cur, wr, wc, fr, fq); S.done(cur); }
        if (!has_next) break;
#pragma unroll
        for (int a = 0; a < 2; ++a)
#pragma unroll
            for (int b = 0; b < 2; ++b)
#pragma unroll
                for (int m = 0; m < 4; ++m)
#pragma unroll
                    for (int n = 0; n < 2; ++n) acc[a][b][m][n] = (f32x4){0.f, 0.f, 0.f, 0.f};
        cur = nxt; cA = nA; cB = nB; ++ui;
        if constexpr (ALIGN_EPI) { if (wr == 1) PG8_BAR; }
    }
    PG8_WAIT_V(0);
    if constexpr (!ALIGN_EPI) { if (wr == 0) PG8_BAR; }
    PG8_BAR;
    if constexpr (Epi::AFTER_DRAIN) { E.fused(acc, cur, wr, wc, fr, fq, lds, wid, lane); S.done(cur); }
#undef PG8_SA
#undef PG8_SB
#undef PG8_STAGE
#undef PG8_LDA
#undef PG8_LDB
#undef PG8_MMA
#undef PG8_WAIT_V
#undef PG8_WAIT_L
#undef PG8_BAR
#undef PG8_SCHED
}
}
#define LAS __attribute__((address_space(3)))
typedef unsigned short bf16_t;
typedef short bf16x8 __attribute__((ext_vector_type(8)));
typedef float f32x4 __attribute__((ext_vector_type(4)));
typedef unsigned u32x4 __attribute__((ext_vector_type(4)));
typedef unsigned u32x2 __attribute__((ext_vector_type(2)));

constexpr int D = 1024, NB = 16, SEQ = 2048, CTXL = 256, DEPTH = 2, DFF = 2816;
constexpr int ML = NB * SEQ, MC = NB * CTXL, MALL = ML + MC;
constexpr int NWIN = 4864;
constexpr int NT = 512;
constexpr float EPS = 1e-6f;
constexpr size_t MiB = 1u << 20;
constexpr size_t WS_MOD = 0;
constexpr size_t WS_W1A = 2 * MiB, WS_W1B = 13 * MiB, WS_WIN = 19 * MiB, WS_WGLU = 29 * MiB, WS_WPA = 30 * MiB, WS_WPB = 31 * MiB, WS_WO = 32 * MiB, WS_W2A = 34 * MiB, WS_W2B = 45 * MiB;
constexpr size_t WS_HC = 51 * MiB, WS_XN = 67 * MiB, WS_YAP = 67 * MiB, WS_O0 = 103 * MiB;
constexpr size_t WS_U = 139 * MiB, WS_QKV = 175 * MiB, WS_Z = 283 * MiB, WS_G = 319 * MiB, WS_AB = 463 * MiB, WS_HID = 139 * MiB;
constexpr size_t WS_FREE = 468 * MiB, WS_O1 = WS_U, WS_MRG = WS_QKV, WS_END = 504 * MiB;
constexpr int LDS_BYTES = 159744;

typedef __bf16 bf16x2_t __attribute__((ext_vector_type(2)));
typedef float f32x2_t __attribute__((ext_vector_type(2)));
__device__ __forceinline__ unsigned pk2(float lo, float hi) { const f32x2_t v = {lo, hi}; const bf16x2_t b = __builtin_convertvector(v, bf16x2_t); return __builtin_bit_cast(unsigned, b); }
__device__ __forceinline__ float bf2f(unsigned short b) { return __uint_as_float(((unsigned)b) << 16); }
__device__ __forceinline__ float bflo(unsigned w) { return __uint_as_float(w << 16); }
__device__ __forceinline__ float bfhi(unsigned w) { return __uint_as_float(w & 0xffff0000u); }
__device__ __forceinline__ bf16_t f2bf(float f) { return (bf16_t)(pk2(f, 0.f) & 0xffffu); }
__device__ __forceinline__ float sigmoidf_(float x) { return __builtin_amdgcn_rcpf(1.0f + __expf(-x)); }
__device__ __forceinline__ float siluf_(float x) { return x * sigmoidf_(x); }
__device__ __forceinline__ float gelu_tanh(float x) { const float z = 0.7978845608028654f * (x + 0.044715f * x * x * x); const float t = 1.0f - 2.0f * __builtin_amdgcn_rcpf(1.0f + __expf(2.0f * z)); return 0.5f * x * (1.0f + t); }
__device__ __forceinline__ float wave_sum(float v) {
#pragma unroll
    for (int o = 1; o < 64; o <<= 1) v += __shfl_xor(v, o);
    return v;
}
__device__ __forceinline__ int opaque_tid() { int t = threadIdx.x; asm volatile("" : "+v"(t)); return t; }
#define LDS_WAIT() asm volatile("s_waitcnt lgkmcnt(0)" ::: "memory")

struct Args { const float* in[34]; };
__device__ __forceinline__ int opaque_zero() { int z = 0; asm volatile("" : "+v"(z)); return __builtin_amdgcn_readfirstlane(z); }
#define CAS __attribute__((address_space(4)))
#define KARG(i) (*(const float* const CAS*)((const CAS char*)__builtin_amdgcn_kernarg_segment_ptr() + 8 * ((i) + opaque_zero())))
#define WSB() ((unsigned char*)KARG(33))
#define WSO(off) ((unsigned char*)KARG(33) + ((size_t)(unsigned)((int)((off) >> 20) + opaque_zero()) << 20))
#define INP(i) KARG(i)

struct EpiSwiGLU {
    static constexpr bool PERM = true, AFTER_DRAIN = false;
    bf16_t* H;
    __device__ __forceinline__ void operator()(const f32x4 (&acc)[2][2][4][2], const pg8::Unit& u, int wr, int wc, int fr, int fq) const {
        const int row0 = u.pm * 256 + wr * 64 + fr, col0 = u.pn * 128 + wc * 32 + 8 * fq;
#pragma unroll
        for (int ai = 0; ai < 2; ++ai)
#pragma unroll
            for (int m = 0; m < 4; ++m) {
                bf16_t* rowp = H + (size_t)(row0 + ai * 128 + m * 16) * DFF + col0;
                const f32x4 g0 = acc[ai][0][m][0], g1 = acc[ai][0][m][1], u0 = acc[ai][1][m][0], u1 = acc[ai][1][m][1];
                u32x4 w;
                w.x = pk2(siluf_(g0[0]) * u0[0], siluf_(g0[1]) * u0[1]); w.y = pk2(siluf_(g0[2]) * u0[2], siluf_(g0[3]) * u0[3]);
                w.z = pk2(siluf_(g1[0]) * u1[0], siluf_(g1[1]) * u1[1]); w.w = pk2(siluf_(g1[2]) * u1[2], siluf_(g1[3]) * u1[3]);
                *(u32x4*)rowp = w;
            }
    }
};
struct EpiResid {
    static constexpr bool PERM = false, AFTER_DRAIN = false;
    const float* src_lat; const float* src_ctx; float* dst_lat; float* dst_ctx; const float* gate; float coef; int row_base;
    __device__ __forceinline__ void operator()(const f32x4 (&acc)[2][2][4][2], const pg8::Unit& u, int wr, int wc, int fr, int fq) const {
        const int rowt = row_base + u.pm * 256; const bool lat = rowt < ML;
        const float* sp = lat ? src_lat + (size_t)rowt * D : src_ctx + (size_t)(rowt - ML) * D;
        float* dp = lat ? dst_lat + (size_t)rowt * D : dst_ctx + (size_t)(rowt - ML) * D;
        const int b = lat ? (rowt >> 11) : 16;
        const int rl = wr * 64 + fr, col0 = u.pn * 256 + wc * 32 + 4 * fq;
        f32x4 gv[2][2];
#pragma unroll
        for (int bj = 0; bj < 2; ++bj)
#pragma unroll
            for (int n = 0; n < 2; ++n) gv[bj][n] = *(const f32x4*)(gate + (size_t)b * 9216 + col0 + bj * 128 + n * 16) * coef;
#pragma unroll
        for (int ai = 0; ai < 2; ++ai)
#pragma unroll
            for (int m = 0; m < 4; ++m) { const size_t off = (size_t)(rl + ai * 128 + m * 16) * D + col0;
#pragma unroll
                for (int bj = 0; bj < 2; ++bj)
#pragma unroll
                    for (int n = 0; n < 2; ++n) { const f32x4 s = *(const f32x4*)(sp + off + bj * 128 + n * 16); *(f32x4*)(dp + off + bj * 128 + n * 16) = s + gv[bj][n] * acc[ai][bj][m][n]; }
                if (m == 3) asm volatile("" ::: "memory"); }
    }
};
struct EpiWin {
    static constexpr bool PERM = true, AFTER_DRAIN = false;
    bf16_t* U; bf16_t* QKV; bf16_t* Z; bf16_t* G; float* AB;
    __device__ __forceinline__ void operator()(const f32x4 (&acc)[2][2][4][2], const pg8::Unit& u, int wr, int wc, int fr, int fq) const {
        const int row0 = u.pm * 256 + wr * 64 + fr, cw = wc * 32 + 8 * fq; const int pn = u.pn;
        if (pn == 18) {
            if (wc == 0) {
#pragma unroll
                for (int ai = 0; ai < 2; ++ai)
#pragma unroll
                    for (int m = 0; m < 4; ++m) { float* rp = AB + (size_t)(row0 + ai * 128 + m * 16) * 32 + 8 * fq; *(f32x4*)rp = acc[ai][0][m][0]; *(f32x4*)(rp + 4) = acc[ai][0][m][1]; }
            }
            return;
        }
        bf16_t* base; int ld, ct; bool sg = false;
        if (pn < 2) { base = U; ld = 512; ct = pn; } else if (pn < 8) { base = QKV; ld = 1536; ct = pn - 2; } else if (pn < 10) { base = Z; ld = 512; ct = pn - 8; } else { base = G; ld = 2048; ct = pn - 10; sg = true; }
#pragma unroll
        for (int ai = 0; ai < 2; ++ai)
#pragma unroll
            for (int m = 0; m < 4; ++m) { bf16_t* rowp = base + (size_t)(row0 + ai * 128 + m * 16) * ld + ct * 256 + cw;
#pragma unroll
                for (int bj = 0; bj < 2; ++bj) { f32x4 v0 = acc[ai][bj][m][0], v1 = acc[ai][bj][m][1];
                    if (sg) {
#pragma unroll
                        for (int j = 0; j < 4; ++j) { v0[j] = sigmoidf_(v0[j]); v1[j] = sigmoidf_(v1[j]); } }
                    u32x4 w; w.x = pk2(v0[0], v0[1]); w.y = pk2(v0[2], v0[3]); w.z = pk2(v1[0], v1[1]); w.w = pk2(v1[2], v1[3]);
                    *(u32x4*)(rowp + bj * 128) = w; } }
    }
};
struct EpiGLU {
    static constexpr bool PERM = true, AFTER_DRAIN = false;
    const bf16_t* pre; bf16_t* out; const float* bias;
    __device__ __forceinline__ void operator()(const f32x4 (&acc)[2][2][4][2], const pg8::Unit& u, int wr, int wc, int fr, int fq) const {
        const int row0 = u.pm * 256 + wr * 64 + fr, col0 = u.pn * 256 + wc * 32 + 8 * fq;
#pragma unroll
        for (int bj = 0; bj < 2; ++bj) { const f32x4 b0 = *(const f32x4*)(bias + col0 + bj * 128), b1 = *(const f32x4*)(bias + col0 + bj * 128 + 4);
#pragma unroll
            for (int ai = 0; ai < 2; ++ai)
#pragma unroll
                for (int m = 0; m < 4; ++m) { const size_t off = (size_t)(row0 + ai * 128 + m * 16) * 512 + col0 + bj * 128;
                    const u32x4 p = *(const u32x4*)(pre + off); const f32x4 v0 = acc[ai][bj][m][0] + b0, v1 = acc[ai][bj][m][1] + b1;
                    u32x4 w;
                    w.x = pk2(bflo(p.x) * sigmoidf_(v0[0]), bfhi(p.x) * sigmoidf_(v0[1])); w.y = pk2(bflo(p.y) * sigmoidf_(v0[2]), bfhi(p.y) * sigmoidf_(v0[3]));
                    w.z = pk2(bflo(p.z) * sigmoidf_(v1[0]), bfhi(p.z) * sigmoidf_(v1[1])); w.w = pk2(bflo(p.w) * sigmoidf_(v1[2]), bfhi(p.w) * sigmoidf_(v1[3]));
                    *(u32x4*)(out + off) = w; } }
    }
};
template <int PASS> struct EpiMerge {
    static constexpr bool PERM = true, AFTER_DRAIN = false;
    const bf16_t* G; bf16_t* MRG;
    __device__ __forceinline__ void operator()(const f32x4 (&acc)[2][2][4][2], const pg8::Unit& u, int wr, int wc, int fr, int fq) const {
        const int row0 = u.pm * 256 + wr * 64 + fr, col0 = u.pn * 256 + wc * 32 + 8 * fq;
#pragma unroll
        for (int ai = 0; ai < 2; ++ai)
#pragma unroll
            for (int m = 0; m < 4; ++m) { const size_t row = (size_t)(row0 + ai * 128 + m * 16);
#pragma unroll
                for (int bj = 0; bj < 2; ++bj) { const u32x4 g = *(const u32x4*)(G + row * 2048 + PASS * 1024 + col0 + bj * 128); bf16_t* op = MRG + row * 1024 + col0 + bj * 128;
                    const f32x4 v0 = acc[ai][bj][m][0], v1 = acc[ai][bj][m][1];
                    float r0 = bflo(g.x) * v0[0], r1 = bfhi(g.x) * v0[1], r2 = bflo(g.y) * v0[2], r3 = bfhi(g.y) * v0[3], r4 = bflo(g.z) * v1[0], r5 = bfhi(g.z) * v1[1], r6 = bflo(g.w) * v1[2], r7 = bfhi(g.w) * v1[3];
                    if (PASS) { const u32x4 o = *(const u32x4*)op; r0 += bflo(o.x); r1 += bfhi(o.x); r2 += bflo(o.y); r3 += bfhi(o.y); r4 += bflo(o.z); r5 += bfhi(o.z); r6 += bflo(o.w); r7 += bfhi(o.w); }
                    u32x4 w; w.x = pk2(r0, r1); w.y = pk2(r2, r3); w.z = pk2(r4, r5); w.w = pk2(r6, r7);
                    *(u32x4*)op = w; } }
    }
};
__device__ __forceinline__ void phase_mod(const Args& a, LAS unsigned char* lds, float* MOD) {
    LAS float* sc = (LAS float*)lds; LAS float* part = sc + 17 * 1024;
    const int tid = opaque_tid();
    const float* c = INP(1); const float* cc = INP(3);
    for (int i = tid; i < 17 * 1024; i += NT) { const float v = i < 16 * 1024 ? c[i] : cc[i - 16 * 1024]; sc[i] = siluf_(v); }
    __syncthreads();
    const int col = tid & 63, ks = tid >> 6;
    for (int item = blockIdx.x; item < 288; item += gridDim.x) {
        const int l = item / 144, n0 = (item % 144) * 64;
        const float* W = INP(4) + (size_t)l * 1024 * 9216 + n0 + col;
        float acc[17];
#pragma unroll
        for (int r = 0; r < 17; ++r) acc[r] = 0.f;
        for (int k0 = ks * 128; k0 < ks * 128 + 128; k0 += 16) { float w[16];
#pragma unroll
            for (int u = 0; u < 16; ++u) w[u] = W[(size_t)(k0 + u) * 9216];
#pragma unroll
            for (int u = 0; u < 16; ++u)
#pragma unroll
                for (int r = 0; r < 17; ++r) acc[r] += sc[r * 1024 + k0 + u] * w[u]; }
#pragma unroll
        for (int r = 0; r < 17; ++r) part[(ks * 17 + r) * 64 + col] = acc[r];
        __syncthreads();
        for (int o = tid; o < 17 * 64; o += NT) { const int r = o >> 6, cl = o & 63; float s = INP(5)[l * 9216 + n0 + cl];
#pragma unroll
            for (int q = 0; q < 8; ++q) s += part[(q * 17 + r) * 64 + cl];
            MOD[(size_t)(l * 17 + r) * 9216 + n0 + cl] = s; }
        __syncthreads();
    }
}

__device__ __forceinline__ int map_col(int type, int dn0) {
    if (type == 0) return dn0;
    if (type == 1) { const int tile = dn0 >> 8, w = dn0 & 255; return w < 128 ? tile * 128 + w : DFF + tile * 128 + (w - 128); }
    if (dn0 < 2048) return dn0;
    if (dn0 < 2560) return 2080 + (dn0 - 2048);
    if (dn0 < 4608) return 2592 + (dn0 - 2560);
    if (dn0 < 4640) return 2048 + (dn0 - 4608);
    return -1;
}
__device__ __forceinline__ void conv_matrix(const float* W, int K, int Nsrc, int Ndst, bf16_t* WT, int type, LAS float* scr, int gw, int NGW, int lane) {
    const int nblk = Ndst / 32, nitems = (K / 64) * nblk;
    for (int item = gw; item < nitems; item += NGW) {
        const int kb = item / nblk, nb = item % nblk, k0 = 64 * kb, dn0 = 32 * nb, sn0 = map_col(type, dn0);
        if (sn0 >= 0) {
            float wv[32];
#pragma unroll
            for (int i = 0; i < 32; ++i) wv[i] = W[(size_t)(k0 + 2 * i + (lane >> 5)) * Nsrc + sn0 + (lane & 31)];
#pragma unroll
            for (int i = 0; i < 32; ++i) scr[(2 * i + (lane >> 5)) * 33 + (lane & 31)] = wv[i];
        } else {
#pragma unroll 8
            for (int i = 0; i < 32; ++i) { const int kk = 2 * i + (lane >> 5); scr[kk * 33 + (lane & 31)] = 0.f; }
        }
        LDS_WAIT();
        const int c = lane & 7;
#pragma unroll
        for (int j = 0; j < 4; ++j) { const int n = (lane >> 3) + 8 * j; const LAS float* s = scr + (8 * c) * 33 + n;
            u32x4 o; o.x = pk2(s[0 * 33], s[1 * 33]); o.y = pk2(s[2 * 33], s[3 * 33]); o.z = pk2(s[4 * 33], s[5 * 33]); o.w = pk2(s[6 * 33], s[7 * 33]);
            *(u32x4*)(WT + (size_t)(dn0 + n) * K + k0 + 8 * c) = o; }
        LDS_WAIT();
    }
}
__device__ __forceinline__ void phase_convert_part(const Args& a, int l, LAS unsigned char* lds, int part, int blk, int nblk) {
    const int tid = opaque_tid(), lane = tid & 63, wave = tid >> 6;
    LAS float* scr = (LAS float*)(lds + wave * 16384);
    const int gw = blk * 8 + wave, NGW = nblk * 8;
    if (part == 0) {
        conv_matrix(INP(7) + (size_t)l * D * 2 * DFF, D, 2 * DFF, 2 * DFF, (bf16_t*)WSO(WS_W1A), 1, scr, gw, NGW, lane);
        conv_matrix(INP(8) + (size_t)l * DFF * D, DFF, D, D, (bf16_t*)WSO(WS_W1B), 0, scr, gw, NGW, lane);
        conv_matrix(INP(10) + (size_t)l * D * 4640, D, 4640, NWIN, (bf16_t*)WSO(WS_WIN), 2, scr, gw, NGW, lane);
    } else {
        conv_matrix(INP(19) + (size_t)l * 512 * 512, 512, 512, 512, (bf16_t*)WSO(WS_WGLU), 0, scr, gw, NGW, lane);
        conv_matrix(INP(25) + (size_t)l * 512 * D, 512, D, D, (bf16_t*)WSO(WS_WPA), 0, scr, gw, NGW, lane);
        conv_matrix(INP(26) + (size_t)l * 512 * D, 512, D, D, (bf16_t*)WSO(WS_WPB), 0, scr, gw, NGW, lane);
        conv_matrix(INP(27) + (size_t)l * D * D, D, D, D, (bf16_t*)WSO(WS_WO), 0, scr, gw, NGW, lane);
        conv_matrix(INP(29) + (size_t)l * D * 2 * DFF, D, 2 * DFF, 2 * DFF, (bf16_t*)WSO(WS_W2A), 1, scr, gw, NGW, lane);
        conv_matrix(INP(30) + (size_t)l * DFF * D, DFF, D, D, (bf16_t*)WSO(WS_W2B), 0, scr, gw, NGW, lane);
    }
}

__device__ __forceinline__ void phase_norm_range(const float* src_lat, const float* src_ctx, const float* nw, const float* modl, int shift_idx, int scale_idx, bf16_t* XN, int r_begin, int r_end, int blk, int nblk) {
    const int tid = opaque_tid(), lane = tid & 63, wave = tid >> 6;
    const int gw = blk * 8 + wave, NGW = nblk * 8;
    for (int rp = (r_begin >> 2) + gw; rp < (r_end >> 2); rp += NGW) {
        f32x4 v[4][4]; float ss[4] = {0.f, 0.f, 0.f, 0.f};
        const int row0 = 4 * rp; const bool lat = row0 < ML;
        const float* xr = lat ? src_lat + (size_t)row0 * D : src_ctx + (size_t)(row0 - ML) * D; const int b = lat ? (row0 >> 11) : 16;
#pragma unroll
        for (int u = 0; u < 4; ++u)
#pragma unroll
            for (int j = 0; j < 4; ++j) v[u][j] = *(const f32x4*)(xr + u * D + lane * 4 + 256 * j);
#pragma unroll
        for (int u = 0; u < 4; ++u)
#pragma unroll
            for (int j = 0; j < 4; ++j) ss[u] += (v[u][j].x * v[u][j].x + v[u][j].y * v[u][j].y) + (v[u][j].z * v[u][j].z + v[u][j].w * v[u][j].w);
        float rr[4];
#pragma unroll
        for (int u = 0; u < 4; ++u) rr[u] = rsqrtf(wave_sum(ss[u]) * (1.0f / D) + EPS);
        const float* sh = modl + (size_t)b * 9216 + shift_idx * 1024; const float* scl = modl + (size_t)b * 9216 + scale_idx * 1024;
#pragma unroll
        for (int j = 0; j < 4; ++j) { const int col = lane * 4 + 256 * j;
            const f32x4 w = *(const f32x4*)(nw + col), s1 = *(const f32x4*)(scl + col), s0 = *(const f32x4*)(sh + col);
            const f32x4 g = w * (s1 + 1.0f);
#pragma unroll
            for (int u = 0; u < 4; ++u) { const f32x4 y = v[u][j] * rr[u] * g + s0; u32x2 o; o.x = pk2(y.x, y.y); o.y = pk2(y.z, y.w); *(u32x2*)(XN + (size_t)(row0 + u) * D + col) = o; } }
    }
}
__device__ __forceinline__ void phase_norm(const float* src_lat, const float* src_ctx, const float* nw, const float* modl, int shift_idx, int scale_idx, bf16_t* XN, int M) {
    phase_norm_range(src_lat, src_ctx, nw, modl, shift_idx, scale_idx, XN, 0, M, (int)blockIdx.x, (int)gridDim.x);
}
__device__ __forceinline__ void phase_final(float* h, const float* nw) {
    const int tid = opaque_tid(), lane = tid & 63, wave = tid >> 6;
    const int gw = blockIdx.x * 8 + wave, NGW = gridDim.x * 8;
    for (int rp = gw; rp < (ML >> 1); rp += NGW) {
        float* xr = h + (size_t)(2 * rp) * D;
        f32x4 v[2][4]; float ss[2] = {0.f, 0.f};
#pragma unroll
        for (int u = 0; u < 2; ++u)
#pragma unroll
            for (int j = 0; j < 4; ++j) v[u][j] = *(const f32x4*)(xr + u * D + lane * 4 + 256 * j);
#pragma unroll
        for (int u = 0; u < 2; ++u)
#pragma unroll
            for (int j = 0; j < 4; ++j) ss[u] += (v[u][j].x * v[u][j].x + v[u][j].y * v[u][j].y) + (v[u][j].z * v[u][j].z + v[u][j].w * v[u][j].w);
        const float r0 = rsqrtf(wave_sum(ss[0]) * (1.0f / D) + EPS), r1 = rsqrtf(wave_sum(ss[1]) * (1.0f / D) + EPS);
#pragma unroll
        for (int j = 0; j < 4; ++j) { const int col = lane * 4 + 256 * j; const f32x4 w = *(const f32x4*)(nw + col);
            *(f32x4*)(xr + col) = v[0][j] * r0 * w; *(f32x4*)(xr + D + col) = v[1][j] * r1 * w; }
    }
}
__device__ __forceinline__ void phase_s5_combine(bf16_t* Y0, const bf16_t* Y1, int M) {
    const size_t nvec = (size_t)M * 512 / 8, stride = (size_t)gridDim.x * NT;
    for (size_t i = (size_t)blockIdx.x * NT + opaque_tid(); i < nvec; i += 4 * stride) {
        u32x4 p[4], q[4];
#pragma unroll
        for (int u = 0; u < 4; ++u) { const size_t k = i + u * stride; if (k < nvec) { p[u] = *(const u32x4*)(Y0 + k * 8); q[u] = *(const u32x4*)(Y1 + k * 8); } }
#pragma unroll
        for (int u = 0; u < 4; ++u) { const size_t k = i + u * stride; if (k < nvec) { u32x4 w;
            w.x = pk2(gelu_tanh(bflo(p[u].x) + bflo(q[u].x)), gelu_tanh(bfhi(p[u].x) + bfhi(q[u].x)));
            w.y = pk2(gelu_tanh(bflo(p[u].y) + bflo(q[u].y)), gelu_tanh(bfhi(p[u].y) + bfhi(q[u].y)));
            w.z = pk2(gelu_tanh(bflo(p[u].z) + bflo(q[u].z)), gelu_tanh(bfhi(p[u].z) + bfhi(q[u].z)));
            w.w = pk2(gelu_tanh(bflo(p[u].w) + bflo(q[u].w)), gelu_tanh(bfhi(p[u].w) + bfhi(q[u].w)));
            *(u32x4*)(Y0 + k * 8) = w; } }
    }
}
__device__ __forceinline__ void phase_gdn_finish(bf16_t* O0, const bf16_t* O1, const bf16_t* Z, const float* dnw, int M, int blk, int nblk) {
    const int tid = opaque_tid(), lane = tid & 63, wave = tid >> 6;
    const int gw = blk * 8 + wave, NGW = nblk * 8;
    const f32x4 w0 = *(const f32x4*)(dnw + (lane & 7) * 8), w1 = *(const f32x4*)(dnw + (lane & 7) * 8 + 4);
    const float ww[8] = { w0.x, w0.y, w0.z, w0.w, w1.x, w1.y, w1.z, w1.w };
    for (int rp = gw; rp < (M >> 2); rp += NGW) {
        u32x4 p[4], q[4], z[4];
#pragma unroll
        for (int u = 0; u < 4; ++u) { const size_t off = (size_t)(4 * rp + u) * 512 + lane * 8; p[u] = *(const u32x4*)(O0 + off); q[u] = *(const u32x4*)(O1 + off); z[u] = *(const u32x4*)(Z + off); }
#pragma unroll
        for (int u = 0; u < 4; ++u) { const size_t off = (size_t)(4 * rp + u) * 512 + lane * 8;
            float o[8] = { bflo(p[u].x) + bflo(q[u].x), bfhi(p[u].x) + bfhi(q[u].x), bflo(p[u].y) + bflo(q[u].y), bfhi(p[u].y) + bfhi(q[u].y), bflo(p[u].z) + bflo(q[u].z), bfhi(p[u].z) + bfhi(q[u].z), bflo(p[u].w) + bflo(q[u].w), bfhi(p[u].w) + bfhi(q[u].w) };
            float ss = 0.f;
#pragma unroll
            for (int j = 0; j < 8; ++j) ss += o[j] * o[j];
            ss += __shfl_xor(ss, 1); ss += __shfl_xor(ss, 2); ss += __shfl_xor(ss, 4);
            const float rn = rsqrtf(ss * (1.0f / 64.0f) + EPS);
            const float zz[8] = { bflo(z[u].x), bfhi(z[u].x), bflo(z[u].y), bfhi(z[u].y), bflo(z[u].z), bfhi(z[u].z), bflo(z[u].w), bfhi(z[u].w) };
            float y[8];
#pragma unroll
            for (int j = 0; j < 8; ++j) y[j] = o[j] * rn * ww[j] * siluf_(zz[j]);
            u32x4 w; w.x = pk2(y[0], y[1]); w.y = pk2(y[2], y[3]); w.z = pk2(y[4], y[5]); w.w = pk2(y[6], y[7]);
            *(u32x4*)(O0 + off) = w; }
    }
}
__device__ __forceinline__ int s5_row(int b, int dir, int n) {
    if (n < CTXL) { const int s = dir ? (CTXL - 1 - n) : n; return ML + b * CTXL + s; }
    const int t = n - CTXL; return b * SEQ + (dir ? (SEQ - 1 - t) : t);
}
#define MFMA16(A_, B_, C_) __builtin_amdgcn_mfma_f32_16x16x32_bf16((A_), (B_), (C_), 0, 0, 0)
__device__ __forceinline__ void phase_s5(const Args& a, int l, LAS unsigned char* lds, const bf16_t* U, bf16_t* Y0, bf16_t* Y1) {
    const int tid = opaque_tid(), lane = tid & 63, wave = __builtin_amdgcn_readfirstlane(tid >> 6), fr = lane & 15, fq = lane >> 4;
    LAS unsigned char* PB0 = lds + (wave >> 1) * 34816; LAS unsigned char* EX = lds + 139264 + wave * 1024; LAS unsigned char* YB = lds + 147456 + wave * 1024;
    const float* lam_re = INP(11); const float* lam_im = INP(12); const float* log_dt = INP(13); const float* b_re = INP(14); const float* b_im = INP(15);
    const float* c_re = INP(16); const float* c_im = INP(17); const float* s5d = INP(18);
    for (int task = blockIdx.x * 8 + wave; task < 2048; task += gridDim.x * 8) {
        const int b = task >> 7, g = (task >> 2) & 31, dir = (task >> 1) & 1, half = task & 1;
        const int pidx = (l * 2 + dir) * 32 + g;
        const float dt = expf(log_dt[pidx]);
        float are[2], aim[2], a8r[2], a8i[2]; bf16x8 Ybb[2][2];
#pragma unroll
        for (int nt = 0; nt < 2; ++nt) {
            const int p = 16 * (2 * half + nt) + fr;
            const float lr = lam_re[pidx * 64 + p], li = lam_im[pidx * 64 + p];
            const float mag = expf(lr * dt), ar = mag * cosf(li * dt), ai = mag * sinf(li * dt), den = lr * lr + li * li;
            const float fre = ((ar - 1.0f) * lr + ai * li) / den, fim = (ai * lr - (ar - 1.0f) * li) / den;
            are[nt] = ar; aim[nt] = ai;
            const float a2r = ar * ar - ai * ai, a2i = 2.0f * ar * ai, a4r = a2r * a2r - a2i * a2i, a4i = 2.0f * a2r * a2i;
            a8r[nt] = a4r * a4r - a4i * a4i; a8i[nt] = 2.0f * a4r * a4i;
            u32x4 wre = {0u, 0u, 0u, 0u}, wim = {0u, 0u, 0u, 0u};
            if (fq < 2) {
                const float* br = b_re + ((size_t)pidx * 64 + p) * 16 + 8 * fq; const float* bi = b_im + ((size_t)pidx * 64 + p) * 16 + 8 * fq;
                float re[8], im[8];
#pragma unroll
                for (int j = 0; j < 8; ++j) { re[j] = fre * br[j] - fim * bi[j]; im[j] = fre * bi[j] + fim * br[j]; }
                wre.x = pk2(re[0], re[1]); wre.y = pk2(re[2], re[3]); wre.z = pk2(re[4], re[5]); wre.w = pk2(re[6], re[7]);
                wim.x = pk2(im[0], im[1]); wim.y = pk2(im[2], im[3]); wim.z = pk2(im[4], im[5]); wim.w = pk2(im[6], im[7]);
            }
            Ybb[nt][0] = __builtin_bit_cast(bf16x8, wre); Ybb[nt][1] = __builtin_bit_cast(bf16x8, wim);
        }
        bf16x8 Yc[4];
#pragma unroll
        for (int ks = 0; ks < 4; ++ks) { const int pf = 4 * ks + fq; float v[8];
#pragma unroll
            for (int j = 0; j < 8; ++j) { const int nt = j >> 1, p = 16 * nt + pf; const size_t ci = ((size_t)pidx * 16 + fr) * 64 + p; v[j] = (j & 1) ? -c_im[ci] : c_re[ci]; }
            u32x4 w; w.x = pk2(v[0], v[1]); w.y = pk2(v[2], v[3]); w.z = pk2(v[4], v[5]); w.w = pk2(v[6], v[7]); Yc[ks] = __builtin_bit_cast(bf16x8, w); }
        const float dsk = s5d[l * 512 + g * 16 + fr];
        bf16_t* Yd = dir ? Y1 : Y0;
        const bool dskip = (dir == 0);
        float cyr[2] = {0.f, 0.f}, cyi[2] = {0.f, 0.f};
        bf16x8 Ydg;
        { float v[8];
#pragma unroll
          for (int j = 0; j < 8; ++j) v[j] = (fq < 2 && 8 * fq + j == fr) ? dsk : 0.f;
          u32x4 w; w.x = pk2(v[0], v[1]); w.y = pk2(v[2], v[3]); w.z = pk2(v[4], v[5]); w.w = pk2(v[6], v[7]); Ydg = __builtin_bit_cast(bf16x8, w); }
        float a16r[2], a16i[2];
#pragma unroll
        for (int nt = 0; nt < 2; ++nt) { a16r[nt] = a8r[nt] * a8r[nt] - a8i[nt] * a8i[nt]; a16i[nt] = 2.0f * a8r[nt] * a8i[nt]; }
        u32x4 nXu[4];
        const int sgn = dir ? -1 : 1;
        const int offU0 = sgn * ((fr >> 2) * 16 + (fr & 3)) * 512 + g * 16 + 8 * (fq & 1), dU = sgn * 4 * 512;
        const int offN0 = sgn * (32 * half + fr) * 512 + g * 16 + 8 * (fq & 1), offN1 = offN0 + sgn * 16 * 512;
        const int offY = sgn * (32 * half + (lane >> 1)) * 512 + g * 16 + 8 * (lane & 1);
#define S5_PREFETCH(N0) do { const bf16_t* Ub_ = U + (size_t)__builtin_amdgcn_readfirstlane(s5_row(b, dir, (N0))) * 512; \
            _Pragma("unroll") for (int m_ = 0; m_ < 4; ++m_) { nXu[m_] = (u32x4){0u, 0u, 0u, 0u}; if (fq < 2) nXu[m_] = *(const u32x4*)(Ub_ + offU0 + m_ * dU); } } while (0)
        S5_PREFETCH(0);
        for (int c = 0; c < 36; ++c) {
            const int n0 = 64 * c;
            LAS unsigned char* PB = PB0 + (c & 1) * 17408;
            bf16x8 Xu[4], Xn[2];
#pragma unroll
            for (int mt = 0; mt < 4; ++mt) Xu[mt] = __builtin_bit_cast(bf16x8, nXu[mt]);
            { u32x4 t0 = {0u, 0u, 0u, 0u}, t1 = t0;
              if (fq < 2 && dskip) { const bf16_t* Ub_ = U + (size_t)__builtin_amdgcn_readfirstlane(s5_row(b, dir, n0)) * 512; t0 = *(const u32x4*)(Ub_ + offN0); t1 = *(const u32x4*)(Ub_ + offN1); }
              Xn[0] = __builtin_bit_cast(bf16x8, t0); Xn[1] = __builtin_bit_cast(bf16x8, t1); }
            if (c + 1 < 36) S5_PREFETCH(n0 + 64);
            float Fre[2], Fim[2];
#pragma unroll
            for (int nt = 0; nt < 2; ++nt) {
                const float ar = are[nt], ai = aim[nt];
                f32x4 bu[4][2];
#pragma unroll
                for (int mt = 0; mt < 4; ++mt)
#pragma unroll
                    for (int ri = 0; ri < 2; ++ri) bu[mt][ri] = MFMA16(Xu[mt], Ybb[nt][ri], ((f32x4){0.f, 0.f, 0.f, 0.f}));
                float s_r = 0.f, s_i = 0.f;
#pragma unroll
                for (int tt = 0; tt < 16; ++tt) { const float br = bu[tt >> 2][0][tt & 3], bi = bu[tt >> 2][1][tt & 3];
                    const float nr = ar * s_r - ai * s_i + br, ni = ar * s_i + ai * s_r + bi; s_r = nr; s_i = ni; }
                Fre[nt] = s_r; Fim[nt] = s_i;
            }
            { const f32x4 w0 = {Fre[0], Fim[0], Fre[1], Fim[1]};
              *(LAS f32x4*)(EX + (fq * 16 + fr) * 16) = w0; }
            LDS_WAIT();
            float cinr[2], cini[2];
            { float Cr[2], Ci[2];
#pragma unroll
              for (int nt = 0; nt < 2; ++nt) { Cr[nt] = cyr[nt]; Ci[nt] = cyi[nt]; cinr[nt] = Cr[nt]; cini[nt] = Ci[nt]; }
#pragma unroll
              for (int q = 0; q < 4; ++q) { const f32x4 g0 = *(const LAS f32x4*)(EX + (q * 16 + fr) * 16);
                  const float Fr[2] = {g0.x, g0.z}, Fi[2] = {g0.y, g0.w};
#pragma unroll
                  for (int nt = 0; nt < 2; ++nt) { const float nCr = a16r[nt] * Cr[nt] - a16i[nt] * Ci[nt] + Fr[nt], nCi = a16r[nt] * Ci[nt] + a16i[nt] * Cr[nt] + Fi[nt]; Cr[nt] = nCr; Ci[nt] = nCi;
                      if (fq == q + 1) { cinr[nt] = nCr; cini[nt] = nCi; } } }
#pragma unroll
              for (int nt = 0; nt < 2; ++nt) { cyr[nt] = Cr[nt]; cyi[nt] = Ci[nt]; } }
            LDS_WAIT();
            asm volatile("" : "+v"(Xu[0]), "+v"(Xu[1]), "+v"(Xu[2]), "+v"(Xu[3]));
#pragma unroll
            for (int nt = 0; nt < 2; ++nt) {
                const float ar = are[nt], ai = aim[nt];
                f32x4 bu[4][2];
#pragma unroll
                for (int mt = 0; mt < 4; ++mt)
#pragma unroll
                    for (int ri = 0; ri < 2; ++ri) bu[mt][ri] = MFMA16(Xu[mt], Ybb[nt][ri], ((f32x4){0.f, 0.f, 0.f, 0.f}));
                float s_r = cinr[nt], s_i = cini[nt];
#pragma unroll
                for (int tt = 0; tt < 16; ++tt) { const float br = bu[tt >> 2][0][tt & 3], bi = bu[tt >> 2][1][tt & 3];
                    const float nr = ar * s_r - ai * s_i + br, ni = ar * s_i + ai * s_r + bi; s_r = nr; s_i = ni;
                    *(LAS unsigned*)(PB + (16 * fq + tt) * 272 + fr * 16 + (2 * half + nt) * 4) = pk2(nr, ni); }
            }
            LDS_WAIT(); __builtin_amdgcn_s_barrier(); asm volatile("" ::: "memory");
#pragma unroll
            for (int m2 = 0; m2 < 2; ++m2) { f32x4 y = {0.f, 0.f, 0.f, 0.f};
#pragma unroll
              for (int ks = 0; ks < 4; ++ks) { const bf16x8 Xs = *(const LAS bf16x8*)(PB + (32 * half + 16 * m2 + fr) * 272 + ks * 64 + fq * 16); y = MFMA16(Xs, Yc[ks], y); }
              if (dskip) y = MFMA16(Xn[m2], Ydg, y);
#pragma unroll
              for (int r = 0; r < 4; ++r) *(LAS bf16_t*)(YB + (16 * m2 + 4 * fq + r) * 32 + fr * 2) = f2bf(y[r]); }
            LDS_WAIT();
            { const u32x4 yv = *(const LAS u32x4*)(YB + lane * 16);
              *(u32x4*)(Yd + (size_t)__builtin_amdgcn_readfirstlane(s5_row(b, dir, n0)) * 512 + offY) = yv; }
            LDS_WAIT();
        }
#undef S5_PREFETCH
    }
}
#ifndef NSUBREP
#define NSUBREP 1
#endif
#ifndef NS12REP
#define NS12REP 1
#endif
constexpr int RS = 144, L_KB = 0, L_KN = 9216, L_QN = 18432, L_KE = 27648, L_QD = 36864, L_KDT = 46080, L_ST = 55296, L_RT = 64512, L_VB = 73728,
              L_RAW = 91136, L_LF = 91136, L_LB = 108544, L_T11T = 113152, L_MT = 117760, L_AT = 122368, L_CW = 131584, L_GC = 135424, L_TB = L_KB, L_VNT = L_QN;
__device__ __forceinline__ f32x4 tile_mma(const LAS unsigned char* X, int xr0, const LAS unsigned char* Y, int yr0, int fr, int fq, f32x4 acc) {
#pragma unroll
    for (int ks = 0; ks < 2; ++ks) {
        const bf16x8 xa = *(const LAS bf16x8*)(X + (xr0 + fr) * RS + ks * 64 + fq * 16);
        const bf16x8 yb = *(const LAS bf16x8*)(Y + (yr0 + fr) * RS + ks * 64 + fq * 16);
        acc = MFMA16(xa, yb, acc);
    }
    return acc;
}
__device__ __forceinline__ int gdn_row(int b, bool isctx, int s) { return isctx ? (ML + b * CTXL + s) : (b * SEQ + (s & 31) * 64 + (s >> 5)); }

#define GBAR() do { asm volatile("s_waitcnt lgkmcnt(0)" ::: "memory"); __builtin_amdgcn_s_barrier(); asm volatile("" ::: "memory"); } while (0)
__device__ __forceinline__ f32x4 tile_mma1(const LAS unsigned char* X, int xoff, const LAS unsigned char* Y, int yoff, f32x4 acc) {
    const bf16x8 xa = *(const LAS bf16x8*)(X + xoff); const bf16x8 yb = *(const LAS bf16x8*)(Y + yoff); return MFMA16(xa, yb, acc);
}
__device__ __forceinline__ void phase_gdn(const Args& a, int l, LAS unsigned char* lds, const bf16_t* QKV, const float* AB, bf16_t* O0, bf16_t* O1) {
    const int tid = opaque_tid(), lane = tid & 63, wave = __builtin_amdgcn_readfirstlane(tid >> 6), fr = lane & 15, fq = lane >> 4;
    LAS float* CW = (LAS float*)(lds + L_CW); LAS float* GC0 = (LAS float*)(lds + L_GC);
    LAS float* VB = (LAS float*)(lds + L_VB); LAS float* LF = (LAS float*)(lds + L_LF);
    for (int task = blockIdx.x; task < 256; task += gridDim.x) {
        const int b = task >> 4, h = (task >> 1) & 7, dir = task & 1;
        bf16_t* Od = dir ? O1 : O0;
        __syncthreads();
        for (int i = tid; i < 5 * 192; i += NT) { const int j = i / 192, ch = i % 192, sel = ch >> 6, cc = ch & 63; CW[i] = INP(21)[(size_t)(l * 5 + j) * 1536 + sel * 512 + 64 * h + cc]; }
        for (int i = tid; i < 64 * RS / 4; i += NT) ((LAS unsigned*)(lds + L_ST))[i] = 0u;
        const float alog = -expf(INP(22)[(l * 2 + dir) * 8 + h]), dtb = INP(23)[(l * 2 + dir) * 8 + h];
        f32x4 Sreg[2] = {{0.f, 0.f, 0.f, 0.f}, {0.f, 0.f, 0.f, 0.f}};
        u32x4 pre[4]; float pa = 0.f, pb = 0.f;
#define GDN_PREFETCH(CC) do { const bool ic_ = (CC) < 4; const int Lq_ = ic_ ? CTXL : SEQ, c_ = ic_ ? (CC) : (CC) - 4; const int sl_ = dir ? (Lq_ - 64 * (c_ + 1)) : 64 * c_; \
            _Pragma("unroll") for (int q_ = 0; q_ < 4; ++q_) { const int it_ = tid + q_ * NT; pre[q_] = (u32x4){0u, 0u, 0u, 0u}; \
                if (it_ < 68 * 24) { const int rr_ = it_ / 24, v_ = it_ % 24, sel_ = v_ >> 3, c8_ = v_ & 7, s_ = sl_ - 2 + rr_; \
                    if (s_ >= 0 && s_ < Lq_) pre[q_] = *(const u32x4*)(QKV + (size_t)gdn_row(b, ic_, s_) * 1536 + sel_ * 512 + 64 * h + 8 * c8_); } } \
            if (wave == 7) { const int s_ = dir ? (sl_ + 63 - lane) : (sl_ + lane); const size_t ro_ = (size_t)gdn_row(b, ic_, s_) * 32; pa = AB[ro_ + dir * 8 + h]; pb = AB[ro_ + 16 + dir * 8 + h]; } } while (0)
#define GDN_GATES(CN) do { LAS float* Gn_ = GC0 + ((CN) & 1) * 256; const float av_ = pa + dtb; const float sp_ = av_ > 20.f ? av_ : log1pf(expf(av_)); float gc_ = alog * sp_; \
            _Pragma("unroll") for (int o_ = 1; o_ < 64; o_ <<= 1) { const float t_ = __shfl_up(gc_, o_); if (lane >= o_) gc_ += t_; } \
            const float g63_ = __shfl(gc_, 63); Gn_[lane] = gc_; Gn_[64 + lane] = sigmoidf_(pb); Gn_[128 + lane] = expf(gc_); Gn_[192 + lane] = expf(g63_ - gc_); } while (0)
#define GDN_STAGE(CN) do { \
            _Pragma("unroll") for (int q_ = 0; q_ < 4; ++q_) { const int it_ = tid + q_ * NT; if (it_ < 68 * 24) *(LAS u32x4*)(lds + L_RAW + (it_ / 24) * 384 + (it_ % 24) * 16) = pre[q_]; } \
            if ((CN) + 1 < 36) GDN_PREFETCH((CN) + 1); } while (0)
        GDN_PREFETCH(0);
        if (wave == 7) GDN_GATES(0);
        GDN_STAGE(0);
        GBAR();
        for (int cc = 0; cc < 36; ++cc) {
            const bool isctx = cc < 4; const int Lq = isctx ? CTXL : SEQ, c = isctx ? cc : cc - 4;
            const int s_lo = dir ? (Lq - 64 * (c + 1)) : 64 * c;
            LAS float* GC = GC0 + (cc & 1) * 256; LAS float* BT = GC + 64; LAS float* EG = GC + 128; LAS float* EKD = GC + 192;
#pragma unroll
            for (int x2 = 0; x2 < 2; ++x2) { const int td = 2 * (wave >> 2) + x2, te = wave & 3; u32x2 o; o.x = pk2(Sreg[x2][0], Sreg[x2][1]); o.y = pk2(Sreg[x2][2], Sreg[x2][3]);
                *(LAS u32x2*)(lds + L_ST + (16 * te + fr) * RS + (16 * td + 4 * fq) * 2) = o; }
            for (int itc = 0; itc < 3; ++itc) {
                const int it = tid + itc * NT, v8 = it & 7, ps = it >> 3, i = ps / 3, sel = ps - 3 * i, ch0 = sel * 64 + v8 * 8;
                const int rc = (dir ? (63 - i) : i) + 2;
                float acc[8];
#pragma unroll
                for (int k = 0; k < 8; ++k) acc[k] = 0.f;
#pragma unroll
                for (int j = 0; j < 5; ++j) { const u32x4 x = *(const LAS u32x4*)(lds + L_RAW + (rc + j - 2) * 384 + ch0 * 2);
                    const f32x4 w0 = *(const LAS f32x4*)(CW + j * 192 + ch0), w1 = *(const LAS f32x4*)(CW + j * 192 + ch0 + 4);
                    acc[0] += w0.x * bflo(x.x); acc[1] += w0.y * bfhi(x.x); acc[2] += w0.z * bflo(x.y); acc[3] += w0.w * bfhi(x.y);
                    acc[4] += w1.x * bflo(x.z); acc[5] += w1.y * bfhi(x.z); acc[6] += w1.z * bflo(x.w); acc[7] += w1.w * bfhi(x.w); }
                float ss = 0.f;
#pragma unroll
                for (int k = 0; k < 8; ++k) { acc[k] = siluf_(acc[k]); ss += acc[k] * acc[k]; }
                ss += __shfl_xor(ss, 1); ss += __shfl_xor(ss, 2); ss += __shfl_xor(ss, 4);
                const float rn = rsqrtf(ss + EPS);
                const float bt = BT[i], eg = EG[i], ekd = EKD[i];
                if (sel == 0) {
                    const float s0 = rn * 0.125f, s1 = s0 * eg; u32x4 w0, w1;
                    w0.x = pk2(acc[0] * s0, acc[1] * s0); w0.y = pk2(acc[2] * s0, acc[3] * s0); w0.z = pk2(acc[4] * s0, acc[5] * s0); w0.w = pk2(acc[6] * s0, acc[7] * s0);
                    w1.x = pk2(acc[0] * s1, acc[1] * s1); w1.y = pk2(acc[2] * s1, acc[3] * s1); w1.z = pk2(acc[4] * s1, acc[5] * s1); w1.w = pk2(acc[6] * s1, acc[7] * s1);
                    *(LAS u32x4*)(lds + L_QN + i * RS + v8 * 16) = w0; *(LAS u32x4*)(lds + L_QD + i * RS + v8 * 16) = w1;
                } else if (sel == 1) {
                    const float s0 = rn, s1 = rn * bt, s2 = rn * eg, s3 = rn * ekd; u32x4 w0, w1, w2;
                    w0.x = pk2(acc[0] * s0, acc[1] * s0); w0.y = pk2(acc[2] * s0, acc[3] * s0); w0.z = pk2(acc[4] * s0, acc[5] * s0); w0.w = pk2(acc[6] * s0, acc[7] * s0);
                    w1.x = pk2(acc[0] * s1, acc[1] * s1); w1.y = pk2(acc[2] * s1, acc[3] * s1); w1.z = pk2(acc[4] * s1, acc[5] * s1); w1.w = pk2(acc[6] * s1, acc[7] * s1);
                    w2.x = pk2(acc[0] * s2, acc[1] * s2); w2.y = pk2(acc[2] * s2, acc[3] * s2); w2.z = pk2(acc[4] * s2, acc[5] * s2); w2.w = pk2(acc[6] * s2, acc[7] * s2);
                    *(LAS u32x4*)(lds + L_KN + i * RS + v8 * 16) = w0; *(LAS u32x4*)(lds + L_KB + i * RS + v8 * 16) = w1; *(LAS u32x4*)(lds + L_KE + i * RS + v8 * 16) = w2;
#pragma unroll
                    for (int k = 0; k < 8; ++k) *(LAS bf16_t*)(lds + L_KDT + (v8 * 8 + k) * RS + i * 2) = f2bf(acc[k] * s3);
                } else {
                    f32x4 w0 = {acc[0] * bt, acc[1] * bt, acc[2] * bt, acc[3] * bt}, w1 = {acc[4] * bt, acc[5] * bt, acc[6] * bt, acc[7] * bt};
                    *(LAS f32x4*)(VB + i * 68 + v8 * 8) = w0; *(LAS f32x4*)(VB + i * 68 + v8 * 8 + 4) = w1;
                }
            }
            GBAR();
            for (int q = wave; q < 10; q += 8) {
                const int ti = q < 1 ? 0 : q < 3 ? 1 : q < 6 ? 2 : 3; const int tj = q - (ti * (ti + 1)) / 2;
                const f32x4 w = tile_mma(lds + L_KB, 16 * ti, lds + L_KN, 16 * tj, fr, fq, (f32x4){0.f, 0.f, 0.f, 0.f});
                const int j = 16 * tj + fr; const float gj = GC[j];
#pragma unroll
                for (int r = 0; r < 4; ++r) { const int i = 16 * ti + 4 * fq + r; const float v = (i > j) ? w[r] * __expf(GC[i] - gj) : 0.f; LF[i * 68 + j] = v;
                    if (ti >= 2 && tj < 2) *(LAS bf16_t*)(lds + L_LB + (i - 32) * RS + j * 2) = f2bf(v); }
            }
            GBAR();
            if (wave == 0) {
                __builtin_amdgcn_s_setprio(3);
                int ln = lane; asm volatile("" : "+v"(ln));
                const int hb = ln >> 5, cl = ln & 31;
                const LAS float* Lb = LF + (32 * hb) * 68 + 32 * hb;
                float x[32];
                f32x4 Lr[2][8];
                Lr[1][0] = *(const LAS f32x4*)(Lb + 1 * 68);
#pragma unroll
                for (int i = 0; i < 32; ++i) {
                    asm volatile("" ::: "memory");
                    if (i >= 1 && i + 1 < 32) {
#pragma unroll
                        for (int v = 0; v < (i + 1 + 3) / 4; ++v) Lr[(i + 1) & 1][v] = *(const LAS f32x4*)(Lb + (i + 1) * 68 + 4 * v);
                    }
                    float a0 = (float)(1u - __builtin_elementwise_min((unsigned)(i ^ cl), 1u)), a1 = 0.f, a2 = 0.f, a3 = 0.f;
#pragma unroll
                    for (int v = 0; v < (i + 3) / 4; ++v) { const f32x4 lv = Lr[i & 1][v];
                        if (4 * v + 0 < i) a0 -= lv.x * x[4 * v + 0];
                        if (4 * v + 1 < i) a1 -= lv.y * x[4 * v + 1];
                        if (4 * v + 2 < i) a2 -= lv.z * x[4 * v + 2];
                        if (4 * v + 3 < i) a3 -= lv.w * x[4 * v + 3]; }
                    x[i] = (a0 + a1) + (a2 + a3);
                    *(LAS bf16_t*)(lds + L_TB + (32 * hb + i) * RS + (32 * hb + cl) * 2) = f2bf(x[i]);
                }
                if (hb == 0) {
#pragma unroll
                    for (int v = 0; v < 4; ++v) { u32x4 w; w.x = pk2(x[8 * v], x[8 * v + 1]); w.y = pk2(x[8 * v + 2], x[8 * v + 3]); w.z = pk2(x[8 * v + 4], x[8 * v + 5]); w.w = pk2(x[8 * v + 6], x[8 * v + 7]);
                        *(LAS u32x4*)(lds + L_T11T + cl * RS + v * 16) = w; }
                }
                LDS_WAIT();
#pragma unroll
                for (int t = 0; t < 4; ++t) { const int it = t >> 1, ct = t & 1;
                    const f32x4 m = tile_mma1(lds + L_LB, (16 * it + fr) * RS + fq * 16, lds + L_T11T, (16 * ct + fr) * RS + fq * 16, (f32x4){0.f, 0.f, 0.f, 0.f});
                    u32x2 o; o.x = pk2(m[0], m[1]); o.y = pk2(m[2], m[3]);
                    *(LAS u32x2*)(lds + L_MT + (16 * ct + fr) * RS + (16 * it + 4 * fq) * 2) = o; }
                LDS_WAIT();
#pragma unroll
                for (int t = 0; t < 4; ++t) { const int it = t >> 1, ct = t & 1;
                    const f32x4 m = tile_mma1(lds + L_TB, (32 + 16 * it + fr) * RS + 64 + fq * 16, lds + L_MT, (16 * ct + fr) * RS + fq * 16, (f32x4){0.f, 0.f, 0.f, 0.f});
#pragma unroll
                    for (int r = 0; r < 4; ++r) *(LAS bf16_t*)(lds + L_TB + (32 + 16 * it + 4 * fq + r) * RS + (16 * ct + fr) * 2) = f2bf(-m[r]); }
                __builtin_amdgcn_s_setprio(0);
            } else {
                const int ord = wave <= 3 ? wave - 1 : (wave == 6 ? 3 : (wave == 7 ? 6 : wave));
                for (int idx = ord; idx < 32; idx += 7) {
                    if (idx < 16) {
                        const int ti = idx >> 2, te = idx & 3;
                        const f32x4 w = tile_mma(lds + L_KE, 16 * ti, lds + L_ST, 16 * te, fr, fq, (f32x4){0.f, 0.f, 0.f, 0.f});
                        float rv[4];
#pragma unroll
                        for (int r = 0; r < 4; ++r) { const int i = 16 * ti + 4 * fq + r; rv[r] = VB[i * 68 + 16 * te + fr] - BT[i] * w[r]; }
                        u32x2 o; o.x = pk2(rv[0], rv[1]); o.y = pk2(rv[2], rv[3]);
                        *(LAS u32x2*)(lds + L_RT + (16 * te + fr) * RS + (16 * ti + 4 * fq) * 2) = o;
                    } else {
                        const int ti = (idx - 16) >> 2, tj = (idx - 16) & 3;
                        f32x4 w = {0.f, 0.f, 0.f, 0.f};
                        if (tj <= ti) w = tile_mma(lds + L_QN, 16 * ti, lds + L_KN, 16 * tj, fr, fq, w);
                        const int j = 16 * tj + fr; const float gj = GC[j];
#pragma unroll
                        for (int r = 0; r < 4; ++r) { const int i = 16 * ti + 4 * fq + r; const float v = (i >= j) ? w[r] * __expf(GC[i] - gj) : 0.f; *(LAS bf16_t*)(lds + L_AT + i * RS + j * 2) = f2bf(v); }
                    }
                }
                if (wave == 7 && cc + 1 < 36) GDN_GATES(cc + 1);
            }
            GBAR();
            {
                const int te = wave & 3, hb2 = wave >> 2;
#pragma unroll
                for (int ti = 0; ti < 4; ++ti) {
                    f32x4 w = tile_mma1(lds + L_TB, (16 * ti + fr) * RS + fq * 16, lds + L_RT, (16 * te + fr) * RS + fq * 16, (f32x4){0.f, 0.f, 0.f, 0.f});
                    if (ti >= 2) w = tile_mma1(lds + L_TB, (16 * ti + fr) * RS + 64 + fq * 16, lds + L_RT, (16 * te + fr) * RS + 64 + fq * 16, w);
                    u32x2 o; o.x = pk2(w[0], w[1]); o.y = pk2(w[2], w[3]);
                    *(LAS u32x2*)(lds + L_VNT + (16 * te + fr) * RS + (16 * ti + 4 * fq) * 2) = o; }
                LDS_WAIT();
                const float gl = EG[63];
#pragma unroll
                for (int x2 = 0; x2 < 2; ++x2) { const int ti = 2 * hb2 + x2;
                    const f32x4 p1 = tile_mma(lds + L_QD, 16 * ti, lds + L_ST, 16 * te, fr, fq, (f32x4){0.f, 0.f, 0.f, 0.f});
                    const f32x4 o = tile_mma(lds + L_AT, 16 * ti, lds + L_VNT, 16 * te, fr, fq, p1);
#pragma unroll
                    for (int r = 0; r < 4; ++r) { const int i = 16 * ti + 4 * fq + r; const int s = dir ? (s_lo + 63 - i) : (s_lo + i);
                        Od[(size_t)gdn_row(b, isctx, s) * 512 + 64 * h + 16 * te + fr] = f2bf(o[r]); }
                    Sreg[x2] = tile_mma(lds + L_KDT, 16 * ti, lds + L_VNT, 16 * te, fr, fq, Sreg[x2] * gl); }
            }
            if (cc + 1 < 36) GDN_STAGE(cc + 1);
            GBAR();
        }
#undef GDN_STAGE
#undef GDN_GATES
#undef GDN_PREFETCH
    }
}
#ifndef GALIGN
#define GALIGN true
#endif
#ifndef GSP2
#define GSP2 true
#endif

#define XB_TMO      128
#define XB_XCNT(j)  (256  + 64 * (j))
#define XB_XSUB(j)  (1280 + 64 * (j))
#define XB_XGEN(j)  (2304 + 64 * (j))
#define XB_TOP      3328
#define XB_TOPGEN   3392
#define XCD_BAR_WORDS 3456
#define XB_SPIN_CAP (1u << 18)
__device__ __forceinline__ unsigned xb_ld(unsigned* p)              { return __hip_atomic_load(p, __ATOMIC_RELAXED, __HIP_MEMORY_SCOPE_AGENT); }
__device__ __forceinline__ unsigned xb_add(unsigned* p, unsigned v) { return __hip_atomic_fetch_add(p, v, __ATOMIC_RELAXED, __HIP_MEMORY_SCOPE_AGENT); }
__device__ __forceinline__ unsigned xb_xcc_id() { return (unsigned)__builtin_amdgcn_s_getreg((3 << 11) | 20) & 0xFu; }
#define XB_SPIN(cond, bar) do { unsigned _sp = 0; while (cond) { __builtin_amdgcn_s_sleep(1); \
    if ((++_sp & 255u) == 0u) { if (xb_ld(&(bar)[XB_TMO])) break; if (_sp > XB_SPIN_CAP) { atomicAdd(&(bar)[XB_TMO], 1u); break; } } } } while (0)

struct XcdBarrier {
    unsigned* bar; unsigned x;
    volatile LAS unsigned* st;
};

__device__ __forceinline__ XcdBarrier xcd_barrier_post(unsigned* bar, volatile LAS unsigned* st) {
    XcdBarrier b; b.bar = bar; b.x = xb_xcc_id(); b.st = st;
    if (threadIdx.x == 0) (void)xb_add(&bar[XB_XCNT(b.x)], 1u);
    return b;
}
__device__ __forceinline__ void xcd_barrier_complete(unsigned* bar, unsigned x, unsigned& nloc, unsigned& nx) {
    const unsigned G = gridDim.x * gridDim.y * gridDim.z;
    unsigned sum, cnt, mine, sp = 0u;
    for (;;) {
        sum = 0u; cnt = 0u; mine = 0u;
#pragma unroll
        for (unsigned j = 0; j < 16; ++j) { const unsigned c = xb_ld(&bar[XB_XCNT(j)]); sum += c; cnt += (c > 0u) ? 1u : 0u; mine = (j == x) ? c : mine; }
        if (sum == G) break;
        __builtin_amdgcn_s_sleep(1);
        if ((++sp & 255u) == 0u) { if (xb_ld(&bar[XB_TMO])) break; if (sp > XB_SPIN_CAP) { atomicAdd(&bar[XB_TMO], 1u); break; } }
    }
    nloc = mine > 0u ? mine : 1u; nx = cnt > 0u ? cnt : 1u;
}

__device__ __forceinline__ void xcd_barrier(const XcdBarrier& b) {
    asm volatile("s_waitcnt vmcnt(0)" ::: "memory");
    __syncthreads();
    if (threadIdx.x == 0) {
        unsigned* bar = b.bar;
        __builtin_amdgcn_s_waitcnt(0);
        unsigned nloc = b.st[0], nx = b.st[1];
        if (nloc == 0u) { xcd_barrier_complete(bar, b.x, nloc, nx); b.st[0] = nloc; b.st[1] = nx; }
        const unsigned old = xb_add(&bar[XB_XSUB(b.x)], 1u);
        const unsigned gen = old / nloc;
        if (old + 1u == (gen + 1u) * nloc) {
            __builtin_amdgcn_fence(__ATOMIC_RELEASE, "agent");
            asm volatile("s_waitcnt vmcnt(0)" ::: "memory");
            const unsigned og = xb_add(&bar[XB_TOP], 1u);
            const unsigned tg = og / nx;
            if (og + 1u == (tg + 1u) * nx) xb_add(&bar[XB_TOPGEN], 1u);
            else XB_SPIN(xb_ld(&bar[XB_TOPGEN]) == tg, bar);
            __builtin_amdgcn_fence(__ATOMIC_ACQUIRE, "agent");
            xb_add(&bar[XB_XGEN(b.x)], 1u);
            asm volatile("s_waitcnt vmcnt(0)" ::: "memory");
        } else {
            XB_SPIN(xb_ld(&bar[XB_XGEN(b.x)]) == gen, bar);
            __builtin_amdgcn_fence(__ATOMIC_ACQUIRE, "agent");
            asm volatile("s_waitcnt vmcnt(0)" ::: "memory");
        }
    }
    __syncthreads();
}


template <class Epi>
__device__ __forceinline__ void run_gemm_sub(LAS unsigned char* lds, const bf16_t* A, const bf16_t* Bt, int M, int N, int K, const Epi& E, int G, int c) {
    const int oz = opaque_zero(); M += oz; N += oz; K += oz;
    pg8::Gemm g{A, Bt, M, N, K}; pg8::StaticOrder S; S.init(M, N, G, c);
    pg8::gemm_phase<Epi, pg8::StaticOrder, GALIGN, GSP2>(lds, g, S, E);
    __syncthreads();
}
template <class Epi>
__device__ __forceinline__ void run_gemm(LAS unsigned char* lds, const bf16_t* A, const bf16_t* Bt, int M, int N, int K, const Epi& E) {
    const int oz = opaque_zero(); M += oz; N += oz; K += oz;
    pg8::Gemm g{A, Bt, M, N, K}; pg8::StaticOrder S; S.init(M, N, (int)gridDim.x, (int)blockIdx.x);
#ifndef NO_GEMM
    pg8::gemm_phase<Epi, pg8::StaticOrder, GALIGN, GSP2>(lds, g, S, E);
#endif
    __syncthreads();
}


#ifdef DBG
__device__ __forceinline__ void dbg16(const bf16_t* p, size_t n, unsigned* flags) {
    unsigned bad = 0; const int tid = opaque_tid();
    for (size_t i = (size_t)blockIdx.x * NT + tid; i < n / 2; i += (size_t)gridDim.x * NT) { const unsigned v = ((const unsigned*)p)[i]; bad += ((v & 0x7F80u) == 0x7F80u) + ((v & 0x7F800000u) == 0x7F800000u); }
    if (bad) atomicAdd(flags, bad);
}
__device__ __forceinline__ void dbg32(const float* p, size_t n, unsigned* flags) {
    unsigned bad = 0; const int tid = opaque_tid();
    for (size_t i = (size_t)blockIdx.x * NT + tid; i < n; i += (size_t)gridDim.x * NT) { const unsigned v = ((const unsigned*)p)[i]; bad += ((v & 0x7F800000u) == 0x7F800000u); }
    if (bad) atomicAdd(flags, bad);
}
#define FLG ((unsigned*)(WSO(WS_MOD) + 1536 * 1024))
#define D16(p, n, bit) do { if (DBG == (bit) && l == 0) { grid.sync(); dbg16((p), (size_t)(n), FLG); } } while (0)
#define D32(p, n, bit) do { if (DBG == (bit) && l == 0) { grid.sync(); dbg32((p), (size_t)(n), FLG); } } while (0)
#define DSTOP(bit) do { if (DBG == (bit) && l == 0) goto dbg_end; } while (0)
#else
#define D16(p, n, bit) do {} while (0)
#define D32(p, n, bit) do {} while (0)
#define DSTOP(bit) do {} while (0)
#endif
#ifdef USE_CG_SYNC
#define GSYNC() grid.sync()
#else
#define GSYNC() do { XcdBarrier xb_; xb_.bar = (unsigned*)(WSO(WS_MOD) + 1792 * 1024); xb_.x = xb_xcc_id(); xb_.st = (volatile LAS unsigned*)(lds + LDS_BYTES - 16); xcd_barrier(xb_); } while (0)
#endif
__global__ void __launch_bounds__(NT, 2) mega_fwd(Args a) {
    extern __shared__ __attribute__((aligned(16))) unsigned char lds_raw[];
    LAS unsigned char* lds = (LAS unsigned char*)lds_raw;
    cg::grid_group grid = cg::this_grid();
    volatile LAS unsigned* xst = (volatile LAS unsigned*)(lds + LDS_BYTES - 16);
    if (threadIdx.x < 4) xst[threadIdx.x] = 0u;
    __syncthreads();
    (void)xcd_barrier_post((unsigned*)(WSO(WS_MOD) + 1792 * 1024), xst);
#define P_(T, off) ((T*)WSO(off))
#define MOD P_(float, WS_MOD)
#define hc P_(float, WS_HC)
#define XN P_(bf16_t, WS_XN)
#define HID P_(bf16_t, WS_HID)
#define U P_(bf16_t, WS_U)
#define QKV P_(bf16_t, WS_QKV)
#define Z P_(bf16_t, WS_Z)
#define G P_(bf16_t, WS_G)
#define AB P_(float, WS_AB)
#define YAP P_(bf16_t, WS_YAP)
#define O0 P_(bf16_t, WS_O0)
#define O1 P_(bf16_t, WS_O1)
#define Y1 P_(bf16_t, WS_FREE)
#define YA P_(bf16_t, WS_FREE)
#define MRG P_(bf16_t, WS_MRG)
#define W1A P_(const bf16_t, WS_W1A)
#define W1B P_(const bf16_t, WS_W1B)
#define WIN P_(const bf16_t, WS_WIN)
#define WGLU P_(const bf16_t, WS_WGLU)
#define WPA P_(const bf16_t, WS_WPA)
#define WPB P_(const bf16_t, WS_WPB)
#define WO P_(const bf16_t, WS_WO)
#define W2A P_(const bf16_t, WS_W2A)
#define W2B P_(const bf16_t, WS_W2B)
#define h ((float*)KARG(32))
#ifndef NO_MOD
    phase_mod(a, lds, MOD);
#endif
    if (blockIdx.x >= 32) {
        phase_convert_part(a, 0, lds, 0, (int)blockIdx.x - 32, (int)gridDim.x - 32);
        phase_convert_part(a, 0, lds, 1, (int)blockIdx.x - 32, (int)gridDim.x - 32);
    }
    grid.sync();
    for (int l = 0; l < DEPTH; ++l) {
        const bool last = (l == DEPTH - 1);
        #define modl (MOD + (size_t)l * 17 * 9216)
        #define src_lat (l == 0 ? INP(0) : h)
#define src_ctx (l == 0 ? INP(2) : hc)
        const int M2 = last ? ML : MALL;
        if (l > 0) phase_convert_part(a, l, lds, 1, (int)blockIdx.x, (int)gridDim.x);
        phase_norm(src_lat, src_ctx, INP(6) + l * D, modl, 0, 1, XN, MALL);
        D32(MOD, 2 * 17 * 9216, 0); D16(W1A, 24 * MiB, 1); D16(XN, (size_t)MALL * D, 2);
        DSTOP(0); DSTOP(1); DSTOP(2);
        GSYNC();
        run_gemm(lds, XN, W1A, MALL, 2 * DFF, D, EpiSwiGLU{HID});
#ifdef REP_UP
        GSYNC();
        run_gemm(lds, XN, W1A, MALL, 2 * DFF, D, EpiSwiGLU{HID});
#endif
        D16(HID, (size_t)MALL * DFF, 3);
        DSTOP(3);
        GSYNC();
#ifndef NO_TAIL
        run_gemm(lds, HID, W1B, ML, D, DFF, EpiResid{src_lat, src_ctx, h, hc, modl + 2 * 1024, 0.5f});
        GSYNC();
        if (blockIdx.x < 64) run_gemm_sub(lds, HID + (size_t)ML * DFF, W1B, MC, D, DFF, EpiResid{src_lat, src_ctx, h, hc, modl + 2 * 1024, 0.5f, ML}, 64, (int)blockIdx.x);
        else phase_norm_range(h, hc, INP(9) + l * D, modl, 3, 4, XN, 0, ML, (int)blockIdx.x - 64, (int)gridDim.x - 64);
        GSYNC();
        phase_norm_range(h, hc, INP(9) + l * D, modl, 3, 4, XN, ML, MALL, (int)blockIdx.x, (int)gridDim.x);
        GSYNC();
#else
        run_gemm(lds, HID, W1B, MALL, D, DFF, EpiResid{src_lat, src_ctx, h, hc, modl + 2 * 1024, 0.5f});
        D32(h, (size_t)ML * D, 4); D32(hc, (size_t)MC * D, 4);
        DSTOP(4);
        GSYNC();
        phase_norm(h, hc, INP(9) + l * D, modl, 3, 4, XN, MALL);
#ifdef REP_NORM
        GSYNC();
        phase_norm(h, hc, INP(9) + l * D, modl, 3, 4, XN, MALL);
#endif
        D16(XN, (size_t)MALL * D, 5);
        DSTOP(5);
        GSYNC();
#endif
        run_gemm(lds, XN, WIN, MALL, NWIN, D, EpiWin{U, QKV, Z, G, AB});
#ifdef REP_WIN
        GSYNC();
        run_gemm(lds, XN, WIN, MALL, NWIN, D, EpiWin{U, QKV, Z, G, AB});
#endif
        D16(U, (size_t)MALL * 512, 6); D16(QKV, (size_t)MALL * 1536, 7); D16(Z, (size_t)MALL * 512, 8); D16(G, (size_t)MALL * 2048, 8); D32(AB, (size_t)MALL * 32, 9);
        DSTOP(6); DSTOP(7); DSTOP(8); DSTOP(9);
        GSYNC();
#ifndef NO_S5
        phase_s5(a, l, lds, U, YAP, Y1);
#ifdef REP_SYNC
        for (int rs = 0; rs < 10; ++rs) GSYNC();
#endif
#ifdef REP_S5
        GSYNC();
        phase_s5(a, l, lds, U, YAP, Y1);
#endif
#endif
        D16(YAP, (size_t)MALL * 512, 10); D16(Y1, (size_t)MALL * 512, 10); D16(O0, (size_t)MALL * 512, 26); D16(O1, (size_t)MALL * 512, 27);
        DSTOP(10); DSTOP(26); DSTOP(27);
        GSYNC();
        phase_s5_combine(YAP, Y1, MALL);
#ifndef NO_GDN
        phase_gdn(a, l, lds, QKV, AB, O0, O1);
#ifdef REP_GDN
        GSYNC();
        phase_gdn(a, l, lds, QKV, AB, O0, O1);
#endif
#endif
        D16(O0, (size_t)MALL * 512, 11); D16(O1, (size_t)MALL * 512, 11); D16(YAP, (size_t)MALL * 512, 12);
        D16(O0, (size_t)MALL * 512, 22); D16(O1, (size_t)MALL * 512, 23); D16(O0, (size_t)ML * 512, 24); D16(O1, (size_t)ML * 512, 25);
        DSTOP(11); DSTOP(12); DSTOP(20); DSTOP(21); DSTOP(22); DSTOP(23); DSTOP(24); DSTOP(25);
        GSYNC();
        if (last) phase_gdn_finish(O0, O1, Z, INP(24) + l * 64, M2, (int)blockIdx.x, (int)gridDim.x);
        else if (blockIdx.x >= 32) phase_gdn_finish(O0, O1, Z, INP(24) + l * 64, M2, (int)blockIdx.x - 32, (int)gridDim.x - 32);
        run_gemm(lds, YAP, WGLU, M2, 512, 512, EpiGLU{YAP, YA, INP(20) + l * 512});
        D16(O0, (size_t)M2 * 512, 13); D16(YA, (size_t)M2 * 512, 13);
        DSTOP(13);
        GSYNC();
        run_gemm(lds, YA, WPA, M2, D, 512, EpiMerge<0>{G, MRG});
        run_gemm(lds, O0, WPB, M2, D, 512, EpiMerge<1>{G, MRG});
        D16(MRG, (size_t)M2 * D, 14);
        DSTOP(14);
        GSYNC();
        run_gemm(lds, MRG, WO, M2, D, D, EpiResid{h, hc, h, hc, modl + 5 * 1024, 1.0f});
        if (!last && blockIdx.x >= 64) phase_convert_part(a, l + 1, lds, 0, (int)blockIdx.x - 64, (int)gridDim.x - 64);
        D32(h, (size_t)ML * D, 15);
        DSTOP(15);
        GSYNC();
        phase_norm(h, hc, INP(28) + l * D, modl, 6, 7, XN, M2);
        GSYNC();
        run_gemm(lds, XN, W2A, M2, 2 * DFF, D, EpiSwiGLU{HID});
        D16(HID, (size_t)M2 * DFF, 16);
        DSTOP(16);
        GSYNC();
        run_gemm(lds, HID, W2B, M2, D, DFF, EpiResid{h, hc, h, hc, modl + 8 * 1024, 0.5f});
        D32(h, (size_t)ML * D, 17);
        DSTOP(17);
        GSYNC();
    }
#ifdef DBG
    dbg_end:
    GSYNC();
    { float* o = h; const int tid = opaque_tid();
      for (size_t i = (size_t)blockIdx.x * NT + tid; i < (size_t)ML * D; i += (size_t)gridDim.x * NT) o[i] = 0.f;
      GSYNC();
      if (blockIdx.x == 0 && tid == 0) { const unsigned f = *FLG; int c = 0; if (f) c = (DBG == 20 || DBG == 21) ? (int)f : 32 - __clz((int)f); o[0] = 5792.6f * (float)c; } }
#else
    phase_final(h, INP(31));
#endif
}

extern "C" void kernel_launch(void* const* d_in, const int* in_sizes, int n_in, void* d_out, int out_size, void* d_ws, size_t ws_size, hipStream_t stream) {
    static int grid_blocks = 0;
    if (grid_blocks == 0) {
        if (n_in != 32 || ws_size < WS_END) { fprintf(stderr, "kernel_launch: unexpected inputs (n_in %d, ws %zu)\n", n_in, ws_size); grid_blocks = -1; return; }
        int dev = 0, cus = 0, per_cu = 0;
        hipGetDevice(&dev);
        hipDeviceGetAttribute(&cus, hipDeviceAttributeMultiprocessorCount, dev);
        if (hipFuncSetAttribute((const void*)mega_fwd, hipFuncAttributeMaxDynamicSharedMemorySize, LDS_BYTES) != hipSuccess) { fprintf(stderr, "kernel_launch: hipFuncSetAttribute failed\n"); grid_blocks = -1; return; }
        if (hipOccupancyMaxActiveBlocksPerMultiprocessor(&per_cu, (const void*)mega_fwd, NT, LDS_BYTES) != hipSuccess || per_cu < 1) { fprintf(stderr, "kernel_launch: occupancy query gave %d\n", per_cu); per_cu = 1; }
        (void)hipGetLastError();
        grid_blocks = cus * 1;
        if (cus != 256) { fprintf(stderr, "kernel_launch: built for a 256-CU device (got %d)\n", cus); grid_blocks = -1; return; }
    }
    if (grid_blocks < 0) return;
#ifdef DBG
    hipMemsetAsync((char*)d_ws + 1536 * 1024, 0, 256, stream);
#endif
    hipMemsetAsync((char*)d_ws + 1792 * 1024, 0, 16384, stream);
    Args a{};
    for (int i = 0; i < 32; ++i) a.in[i] = (const float*)d_in[i];
    a.in[32] = (const float*)d_out; a.in[33] = (const float*)d_ws;
    void* args[] = {&a};
    hipError_t e = hipLaunchCooperativeKernel((const void*)mega_fwd, dim3(grid_blocks), dim3(NT), args, LDS_BYTES, stream);
    if (e != hipSuccess) fprintf(stderr, "cooperative launch failed: %s (grid %d)\n", hipGetErrorString(e), grid_blocks);
}
```

```cpp
#include <hip/hip_runtime.h>
#include <hip/hip_cooperative_groups.h>
#include <cstdio>
#include <cstdint>
namespace cg = cooperative_groups;
namespace pg8 {
#define PG8_LAS __attribute__((address_space(3)))
typedef unsigned short bf16_t;
typedef short bf16x8 __attribute__((ext_vector_type(8)));
typedef float f32x4 __attribute__((ext_vector_type(4)));
typedef unsigned u32x4 __attribute__((ext_vector_type(4)));
constexpr int BM = 256, BK = 64, HALF = 128, HTB = HALF * BK * 2  , STAGE_BYTES = 8 * HTB, NXCD = 8, WGM = 8;

__host__ __device__ __forceinline__ int lds_byte(int r, int c) { const int st = (r >> 4) * 2 + (c >> 5), rr = r & 15, cc = c & 31, ob = rr * 64 + cc * 2; return st * 1024 + (ob ^ (((ob >> 9) & 1) << 5)); }
__host__ __device__ __forceinline__ void stage_rc(int b, int& R, int& C) { const int st = b / 1024, sb = b % 1024, swz = sb ^ (((sb >> 9) & 1) << 5); R = (st >> 1) * 16 + swz / 64; C = (st & 1) * 32 + (swz % 64) / 2; }
__host__ __device__ __forceinline__ int perm32(int rho) { const int n = rho >> 4, i = rho & 15; return 8 * (i >> 2) + 4 * n + (i & 3); }

struct Unit { int pm, pn; };
struct Gemm { const bf16_t* A; const bf16_t* Bt; int M, N, K; };

struct StaticOrder {
    int nM, nN, nwg, G, c;
    __host__ __device__ void init(int M, int N, int G_, int c_) { nM = M / BM; nN = N / BM; nwg = nM * nN; G = G_; c = c_; }
    __host__ __device__ bool next(int i, Unit& u) const {
        const long L = (long)i * G + c; if (L >= nwg) return false;
        int wgid = (int)L; { const int q = nwg / NXCD, r = nwg % NXCD, xcd = wgid % NXCD, off = wgid / NXCD; wgid = (xcd < r ? xcd * (q + 1) : r * (q + 1) + (xcd - r) * q) + off; }
        const int nig = WGM * nN, gid = wgid / nig, fm = gid * WGM, gsz = (nM - fm) < WGM ? (nM - fm) : WGM;
        u.pm = fm + ((wgid % nig) % gsz); u.pn = (wgid % nig) / gsz; return true;
    }
    __device__ __forceinline__ void a_ready(const Unit&) const {}
    __device__ __forceinline__ void done(const Unit&) const {}
};
__device__ __forceinline__ unsigned cvt_pk_bf16(float lo, float hi) { unsigned r; asm volatile("v_cvt_pk_bf16_f32 %0, %1, %2" : "=v"(r) : "v"(lo), "v"(hi)); return r; }
template <class Epi, class Sched, bool ALIGN_EPI = false, bool SP2 = false>
__device__ __forceinline__ void gemm_phase(PG8_LAS unsigned char* lds, const Gemm g, const Sched& S, const Epi& E) {
    int tid_ = threadIdx.x; asm volatile("" : "+v"(tid_)); const int tid = tid_, wid = __builtin_amdgcn_readfirstlane(tid >> 6), lane = tid & 63, wr = wid >> 2, wc = wid & 3, fr = lane & 15, fq = lane >> 4;
    const int K = g.K, nt = K / BK;
    unsigned voffA[2], voffB[2];
#pragma unroll
    for (int i = 0; i < 2; ++i) { int R, C; stage_rc(tid * 16 + i * 8192, R, C); const int Rb = Epi::PERM ? ((R & ~31) + perm32(R & 31)) : R;
        voffA[i] = (unsigned)(R * K + C) * 2u; voffB[i] = (unsigned)(Rb * K + C) * 2u; }
    const size_t kstep = (size_t)(BK * 2);
    const size_t hstep = (size_t)HALF * K * 2;
    const size_t tstep = 2 * hstep;
    const unsigned ldsw = (unsigned)wid * 1024u;
    const int aoff = lds_byte(wr * 64 + fr, fq * 8), boff = lds_byte(wc * 32 + fr, fq * 8);
#define PG8_SA(b, h) (((b) * 2 + (h)) * HTB)
#define PG8_SB(b, h) ((4 + (b) * 2 + (h)) * HTB)
#define PG8_STAGE(bufoff, gbase, voff) do { _Pragma("unroll") for (int _i = 0; _i < 2; ++_i) \
        __builtin_amdgcn_global_load_lds((const unsigned*)((const char*)(gbase) + (voff)[_i]), (PG8_LAS unsigned*)(lds + (bufoff) + ldsw + _i * 8192), 16, 0, 0); } while (0)
#define PG8_LDA(dst, b, h) do { _Pragma("unroll") for (int m = 0; m < 4; ++m) _Pragma("unroll") for (int k = 0; k < 2; ++k) dst[m][k] = *(const PG8_LAS bf16x8*)(lds + PG8_SA(b, h) + aoff + m * 2048 + k * 1024); } while (0)
#define PG8_LDB(dst, b, h) do { _Pragma("unroll") for (int n = 0; n < 2; ++n) _Pragma("unroll") for (int k = 0; k < 2; ++k) dst[n][k] = *(const PG8_LAS bf16x8*)(lds + PG8_SB(b, h) + boff + n * 2048 + k * 1024); } while (0)
#define PG8_MMA(ai, bj, At, Bt) do { __builtin_amdgcn_s_setprio(1); _Pragma("unroll") for (int m = 0; m < 4; ++m) _Pragma("unroll") for (int n = 0; n < 2; ++n) _Pragma("unroll") for (int k = 0; k < 2; ++k) \
        acc[ai][bj][m][n] = __builtin_amdgcn_mfma_f32_16x16x32_bf16(Bt[n][k], At[m][k], acc[ai][bj][m][n], 0, 0, 0); __builtin_amdgcn_s_setprio(0); } while (0)
#define PG8_WAIT_V(n) asm volatile("s_waitcnt vmcnt(" #n ")" ::: "memory")
#define PG8_WAIT_L(n) asm volatile("s_waitcnt lgkmcnt(" #n ")" ::: "memory")
#define PG8_BAR __builtin_amdgcn_s_barrier()
#define PG8_SCHED __builtin_amdgcn_sched_barrier(0)
    Unit cur, nxt; int ui = 0;
    if (!S.next(0, cur)) return;
    f32x4 acc[2][2][4][2];
#pragma unroll
    for (int a = 0; a < 2; ++a)
#pragma unroll
        for (int b = 0; b < 2; ++b)
#pragma unroll
            for (int m = 0; m < 4; ++m)
#pragma unroll
                for (int n = 0; n < 2; ++n) acc[a][b][m][n] = (f32x4){0.f, 0.f, 0.f, 0.f};
    bf16x8 At[4][2], B0[2][2], B1[2][2];
    const char* cA = (const char*)g.A + (size_t)cur.pm * tstep; const char* cB = (const char*)g.Bt + (size_t)cur.pn * tstep;
    S.a_ready(cur);
    if constexpr (SP2) {
        PG8_STAGE(PG8_SB(0, 0), cB, voffB); PG8_STAGE(PG8_SB(0, 1), cB + hstep, voffB); PG8_STAGE(PG8_SA(0, 0), cA, voffA); PG8_STAGE(PG8_SA(0, 1), cA + hstep, voffA);
        if (wr == 1) PG8_BAR;
        PG8_WAIT_V(2); PG8_BAR;
        PG8_STAGE(PG8_SB(1, 0), cB + kstep, voffB); PG8_STAGE(PG8_SA(1, 0), cA + kstep, voffA); PG8_STAGE(PG8_SB(1, 1), cB + hstep + kstep, voffB);
        PG8_WAIT_V(6); PG8_BAR;
    } else {
        PG8_STAGE(PG8_SB(0, 0), cB, voffB); PG8_STAGE(PG8_SA(0, 0), cA, voffA); PG8_STAGE(PG8_SB(0, 1), cB + hstep, voffB); PG8_STAGE(PG8_SA(0, 1), cA + hstep, voffA);
        if (wr == 1) PG8_BAR;
        PG8_WAIT_V(4); PG8_BAR;
        PG8_STAGE(PG8_SB(1, 0), cB + kstep, voffB); PG8_STAGE(PG8_SA(1, 0), cA + kstep, voffA); PG8_STAGE(PG8_SB(1, 1), cB + hstep + kstep, voffB);
        PG8_WAIT_V(6); PG8_BAR;
    }
    for (;;) {
        const bool has_next = S.next(ui + 1, nxt);
        const char* nA = has_next ? (const char*)g.A + (size_t)nxt.pm * tstep : cA; const char* nB = has_next ? (const char*)g.Bt + (size_t)nxt.pn * tstep : cB;
        for (int t = 0; t < nt; t += 2) {
            const bool last = (t == nt - 2);
            const char* a1 = cA + (size_t)(t + 1) * kstep;
            const char* a2 = last ? nA : cA + (size_t)(t + 2) * kstep; const char* b2 = last ? nB : cB + (size_t)(t + 2) * kstep;
            const char* a3 = a2 + kstep; const char* b3 = b2 + kstep;
            if (last && has_next) S.a_ready(nxt);
            if constexpr (SP2) {
            PG8_LDB(B0, 0, 0); PG8_LDB(B1, 0, 1); PG8_SCHED; PG8_LDA(At, 0, 0); PG8_STAGE(PG8_SA(1, 1), a1 + hstep, voffA);
            PG8_WAIT_V(8); PG8_WAIT_L(0); PG8_BAR; PG8_MMA(0, 0, At, B0); PG8_MMA(0, 1, At, B1); PG8_BAR; PG8_SCHED;
            PG8_LDA(At, 0, 1); PG8_STAGE(PG8_SB(0, 0), b2, voffB); PG8_STAGE(PG8_SB(0, 1), b2 + hstep, voffB); PG8_STAGE(PG8_SA(0, 0), a2, voffA);
            PG8_WAIT_V(8); PG8_WAIT_L(0); PG8_BAR; PG8_MMA(1, 0, At, B0); PG8_MMA(1, 1, At, B1); PG8_BAR; PG8_SCHED;
            PG8_LDB(B0, 1, 0); PG8_LDB(B1, 1, 1); PG8_SCHED; PG8_LDA(At, 1, 0); PG8_STAGE(PG8_SA(0, 1), a2 + hstep, voffA);
            PG8_WAIT_V(8); PG8_WAIT_L(0); PG8_BAR; PG8_MMA(0, 0, At, B0); PG8_MMA(0, 1, At, B1); PG8_BAR; PG8_SCHED;
            PG8_LDA(At, 1, 1); PG8_STAGE(PG8_SB(1, 0), b3, voffB); PG8_STAGE(PG8_SB(1, 1), b3 + hstep, voffB); PG8_STAGE(PG8_SA(1, 0), a3, voffA);
            PG8_WAIT_V(8); PG8_WAIT_L(0); PG8_BAR; PG8_MMA(1, 0, At, B0); PG8_MMA(1, 1, At, B1); PG8_BAR; PG8_SCHED;
            } else {
            PG8_LDB(B0, 0, 0); PG8_SCHED; PG8_LDA(At, 0, 0); PG8_STAGE(PG8_SA(1, 1), a1 + hstep, voffA);
            PG8_WAIT_L(8); PG8_BAR; PG8_WAIT_L(0); PG8_MMA(0, 0, At, B0); PG8_BAR; PG8_SCHED;
            PG8_LDB(B1, 0, 1); PG8_STAGE(PG8_SB(0, 0), b2, voffB);
            PG8_BAR; PG8_WAIT_L(0); PG8_MMA(0, 1, At, B1); PG8_BAR;
            PG8_LDA(At, 0, 1); PG8_STAGE(PG8_SA(0, 0), a2, voffA);
            PG8_BAR; PG8_WAIT_L(0); PG8_MMA(1, 0, At, B0); PG8_BAR; PG8_SCHED;
            PG8_STAGE(PG8_SB(0, 1), b2 + hstep, voffB);
            PG8_WAIT_V(6); PG8_BAR; PG8_MMA(1, 1, At, B1); PG8_BAR;
            PG8_LDB(B0, 1, 0); PG8_SCHED; PG8_LDA(At, 1, 0); PG8_STAGE(PG8_SA(0, 1), a2 + hstep, voffA);
            PG8_WAIT_L(8); PG8_BAR; PG8_WAIT_L(0); PG8_MMA(0, 0, At, B0); PG8_BAR; PG8_SCHED;
            PG8_LDB(B1, 1, 1); PG8_STAGE(PG8_SB(1, 0), b3, voffB);
            PG8_BAR; PG8_WAIT_L(0); PG8_MMA(0, 1, At, B1); PG8_BAR;
            PG8_LDA(At, 1, 1); PG8_STAGE(PG8_SA(1, 0), a3, voffA);
            PG8_BAR; PG8_WAIT_L(0); PG8_MMA(1, 0, At, B0); PG8_BAR; PG8_SCHED;
            PG8_STAGE(PG8_SB(1, 1), b3 + hstep, voffB);
            PG8_WAIT_V(6); PG8_BAR; PG8_MMA(1, 1, At, B1); PG8_BAR;
            }
        }
        if constexpr (ALIGN_EPI) { if (wr == 0) PG8_BAR; }
        if constexpr (!Epi::AFTER_DRAIN) { E(acc, cur, wr, wc, fr, fq); S.done(cur); }
        if (!has_next) break;
#pragma unroll
        for (int a = 0; a < 2; ++a)
#pragma unroll
            for (int b = 0; b < 2; ++b)
#pragma unroll
                for (int m = 0; m < 4; ++m)
#pragma unroll
                    for (int n = 0; n < 2; ++n) acc[a][b][m][n] = (f32x4){0.f, 0.f, 0.f, 0.f};
        cur = nxt; cA = nA; cB = nB; ++ui;
        if constexpr (ALIGN_EPI) { if (wr == 1) PG8_BAR; }
    }
    PG8_WAIT_V(0);
    if constexpr (!ALIGN_EPI) { if (wr == 0) PG8_BAR; }
    PG8_BAR;
    if constexpr (Epi::AFTER_DRAIN) { E.fused(acc, cur, wr, wc, fr, fq, lds, wid, lane); S.done(cur); }
#undef PG8_SA
#undef PG8_SB
#undef PG8_STAGE
#undef PG8_LDA
#undef PG8_LDB
#undef PG8_MMA
#undef PG8_WAIT_V
#undef PG8_WAIT_L
#undef PG8_BAR
#undef PG8_SCHED
}
}
#define LAS __attribute__((address_space(3)))
typedef unsigned short bf16_t;
typedef short bf16x8 __attribute__((ext_vector_type(8)));
typedef float f32x4 __attribute__((ext_vector_type(4)));
typedef unsigned u32x4 __attribute__((ext_vector_type(4)));
typedef unsigned u32x2 __attribute__((ext_vector_type(2)));

constexpr int D = 1024, NB = 16, SEQ = 2048, CTXL = 256, DEPTH = 2, DFF = 2816;
constexpr int ML = NB * SEQ, MC = NB * CTXL, MALL = ML + MC;
constexpr int NWIN = 4864;
constexpr int NT = 512;
constexpr float EPS = 1e-6f;
constexpr size_t MiB = 1u << 20;
constexpr size_t WS_MOD = 0;
constexpr size_t WS_W1A = 2 * MiB, WS_W1B = 13 * MiB, WS_WIN = 19 * MiB, WS_WGLU = 29 * MiB, WS_WPA = 30 * MiB, WS_WPB = 31 * MiB, WS_WO = 32 * MiB, WS_W2A = 34 * MiB, WS_W2B = 45 * MiB;
constexpr size_t WS_HC = 51 * MiB, WS_XN = 67 * MiB, WS_YAP = 67 * MiB, WS_O0 = 103 * MiB;
constexpr size_t WS_U = 139 * MiB, WS_QKV = 175 * MiB, WS_Z = 283 * MiB, WS_G = 319 * MiB, WS_AB = 463 * MiB, WS_HID = 139 * MiB;
constexpr size_t WS_FREE = 468 * MiB, WS_O1 = WS_U, WS_MRG = WS_QKV, WS_END = 504 * MiB;
constexpr int LDS_BYTES = 159744;

typedef __bf16 bf16x2_t __attribute__((ext_vector_type(2)));
typedef float f32x2_t __attribute__((ext_vector_type(2)));
__device__ __forceinline__ unsigned pk2(float lo, float hi) { const f32x2_t v = {lo, hi}; const bf16x2_t b = __builtin_convertvector(v, bf16x2_t); return __builtin_bit_cast(unsigned, b); }
__device__ __forceinline__ float bf2f(unsigned short b) { return __uint_as_float(((unsigned)b) << 16); }
__device__ __forceinline__ float bflo(unsigned w) { return __uint_as_float(w << 16); }
__device__ __forceinline__ float bfhi(unsigned w) { return __uint_as_float(w & 0xffff0000u); }
__device__ __forceinline__ bf16_t f2bf(float f) { return (bf16_t)(pk2(f, 0.f) & 0xffffu); }
__device__ __forceinline__ float sigmoidf_(float x) { return __builtin_amdgcn_rcpf(1.0f + __expf(-x)); }
__device__ __forceinline__ float siluf_(float x) { return x * sigmoidf_(x); }
__device__ __forceinline__ float gelu_tanh(float x) { const float z = 0.7978845608028654f * (x + 0.044715f * x * x * x); const float t = 1.0f - 2.0f * __builtin_amdgcn_rcpf(1.0f + __expf(2.0f * z)); return 0.5f * x * (1.0f + t); }
__device__ __forceinline__ float wave_sum(float v) {
#pragma unroll
    for (int o = 1; o < 64; o <<= 1) v += __shfl_xor(v, o);
    return v;
}
__device__ __forceinline__ int opaque_tid() { int t = threadIdx.x; asm volatile("" : "+v"(t)); return t; }
#define LDS_WAIT() asm volatile("s_waitcnt lgkmcnt(0)" ::: "memory")

struct Args { const float* in[34]; };
__device__ __forceinline__ int opaque_zero() { int z = 0; asm volatile("" : "+v"(z)); return __builtin_amdgcn_readfirstlane(z); }
#define CAS __attribute__((address_space(4)))
#define KARG(i) (*(const float* const CAS*)((const CAS char*)__builtin_amdgcn_kernarg_segment_ptr() + 8 * ((i) + opaque_zero())))
#define WSB() ((unsigned char*)KARG(33))
#define WSO(off) ((unsigned char*)KARG(33) + ((size_t)(unsigned)((int)((off) >> 20) + opaque_zero()) << 20))
#define INP(i) KARG(i)

struct EpiSwiGLU {
    static constexpr bool PERM = true, AFTER_DRAIN = false;
    bf16_t* H;
    __device__ __forceinline__ void operator()(const f32x4 (&acc)[2][2][4][2], const pg8::Unit& u, int wr, int wc, int fr, int fq) const {
        const int row0 = u.pm * 256 + wr * 64 + fr, col0 = u.pn * 128 + wc * 32 + 8 * fq;
#pragma unroll
        for (int ai = 0; ai < 2; ++ai)
#pragma unroll
            for (int m = 0; m < 4; ++m) {
                bf16_t* rowp = H + (size_t)(row0 + ai * 128 + m * 16) * DFF + col0;
                const f32x4 g0 = acc[ai][0][m][0], g1 = acc[ai][0][m][1], u0 = acc[ai][1][m][0], u1 = acc[ai][1][m][1];
                u32x4 w;
                w.x = pk2(siluf_(g0[0]) * u0[0], siluf_(g0[1]) * u0[1]); w.y = pk2(siluf_(g0[2]) * u0[2], siluf_(g0[3]) * u0[3]);
                w.z = pk2(siluf_(g1[0]) * u1[0], siluf_(g1[1]) * u1[1]); w.w = pk2(siluf_(g1[2]) * u1[2], siluf_(g1[3]) * u1[3]);
                *(u32x4*)rowp = w;
            }
    }
};
struct EpiResid {
    static constexpr bool PERM = false, AFTER_DRAIN = false;
    const float* src_lat; const float* src_ctx; float* dst_lat; float* dst_ctx; const float* gate; float coef; int row_base;
    __device__ __forceinline__ void operator()(const f32x4 (&acc)[2][2][4][2], const pg8::Unit& u, int wr, int wc, int fr, int fq) const {
        const int rowt = row_base + u.pm * 256; const bool lat = rowt < ML;
        const float* sp = lat ? src_lat + (size_t)rowt * D : src_ctx + (size_t)(rowt - ML) * D;
        float* dp = lat ? dst_lat + (size_t)rowt * D : dst_ctx + (size_t)(rowt - ML) * D;
        const int b = lat ? (rowt >> 11) : 16;
        const int rl = wr * 64 + fr, col0 = u.pn * 256 + wc * 32 + 4 * fq;
        f32x4 gv[2][2];
#pragma unroll
        for (int bj = 0; bj < 2; ++bj)
#pragma unroll
            for (int n = 0; n < 2; ++n) gv[bj][n] = *(const f32x4*)(gate + (size_t)b * 9216 + col0 + bj * 128 + n * 16) * coef;
#pragma unroll
        for (int ai = 0; ai < 2; ++ai)
#pragma unroll
            for (int m = 0; m < 4; ++m) { const size_t off = (size_t)(rl + ai * 128 + m * 16) * D + col0;
#pragma unroll
                for (int bj = 0; bj < 2; ++bj)
#pragma unroll
                    for (int n = 0; n < 2; ++n) { const f32x4 s = *(const f32x4*)(sp + off + bj * 128 + n * 16); *(f32x4*)(dp + off + bj * 128 + n * 16) = s + gv[bj][n] * acc[ai][bj][m][n]; }
                if (m == 3) asm volatile("" ::: "memory"); }
    }
};
struct EpiWin {
    static constexpr bool PERM = true, AFTER_DRAIN = false;
    bf16_t* U; bf16_t* QKV; bf16_t* Z; bf16_t* G; float* AB;
    __device__ __forceinline__ void operator()(const f32x4 (&acc)[2][2][4][2], const pg8::Unit& u, int wr, int wc, int fr, int fq) const {
        const int row0 = u.pm * 256 + wr * 64 + fr, cw = wc * 32 + 8 * fq; const int pn = u.pn;
        if (pn == 18) {
            if (wc == 0) {
#pragma unroll
                for (int ai = 0; ai < 2; ++ai)
#pragma unroll
                    for (int m = 0; m < 4; ++m) { float* rp = AB + (size_t)(row0 + ai * 128 + m * 16) * 32 + 8 * fq; *(f32x4*)rp = acc[ai][0][m][0]; *(f32x4*)(rp + 4) = acc[ai][0][m][1]; }
            }
            return;
        }
        bf16_t* base; int ld, ct; bool sg = false;
        if (pn < 2) { base = U; ld = 512; ct = pn; } else if (pn < 8) { base = QKV; ld = 1536; ct = pn - 2; } else if (pn < 10) { base = Z; ld = 512; ct = pn - 8; } else { base = G; ld = 2048; ct = pn - 10; sg = true; }
#pragma unroll
        for (int ai = 0; ai < 2; ++ai)
#pragma unroll
            for (int m = 0; m < 4; ++m) { bf16_t* rowp = base + (size_t)(row0 + ai * 128 + m * 16) * ld + ct * 256 + cw;
#pragma unroll
                for (int bj = 0; bj < 2; ++bj) { f32x4 v0 = acc[ai][bj][m][0], v1 = acc[ai][bj][m][1];
                    if (sg) {
#pragma unroll
                        for (int j = 0; j < 4; ++j) { v0[j] = sigmoidf_(v0[j]); v1[j] = sigmoidf_(v1[j]); } }
                    u32x4 w; w.x = pk2(v0[0], v0[1]); w.y = pk2(v0[2], v0[3]); w.z = pk2(v1[0], v1[1]); w.w = pk2(v1[2], v1[3]);
                    *(u32x4*)(rowp + bj * 128) = w; } }
    }
};
struct EpiGLU {
    static constexpr bool PERM = true, AFTER_DRAIN = false;
    const bf16_t* pre; bf16_t* out; const float* bias;
    __device__ __forceinline__ void operator()(const f32x4 (&acc)[2][2][4][2], const pg8::Unit& u, int wr, int wc, int fr, int fq) const {
        const int row0 = u.pm * 256 + wr * 64 + fr, col0 = u.pn * 256 + wc * 32 + 8 * fq;
#pragma unroll
        for (int bj = 0; bj < 2; ++bj) { const f32x4 b0 = *(const f32x4*)(bias + col0 + bj * 128), b1 = *(const f32x4*)(bias + col0 + bj * 128 + 4);
#pragma unroll
            for (int ai = 0; ai < 2; ++ai)
#pragma unroll
                for (int m = 0; m < 4; ++m) { const size_t off = (size_t)(row0 + ai * 128 + m * 16) * 512 + col0 + bj * 128;
                    const u32x4 p = *(const u32x4*)(pre + off); const f32x4 v0 = acc[ai][bj][m][0] + b0, v1 = acc[ai][bj][m][1] + b1;
                    u32x4 w;
                    w.x = pk2(bflo(p.x) * sigmoidf_(v0[0]), bfhi(p.x) * sigmoidf_(v0[1])); w.y = pk2(bflo(p.y) * sigmoidf_(v0[2]), bfhi(p.y) * sigmoidf_(v0[3]));
                    w.z = pk2(bflo(p.z) * sigmoidf_(v1[0]), bfhi(p.z) * sigmoidf_(v1[1])); w.w = pk2(bflo(p.w) * sigmoidf_(v1[2]), bfhi(p.w) * sigmoidf_(v1[3]));
                    *(u32x4*)(out + off) = w; } }
    }
};
template <int PASS> struct EpiMerge {
    static constexpr bool PERM = true, AFTER_DRAIN = false;
    const bf16_t* G; bf16_t* MRG;
    __device__ __forceinline__ void operator()(const f32x4 (&acc)[2][2][4][2], const pg8::Unit& u, int wr, int wc, int fr, int fq) const {
        const int row0 = u.pm * 256 + wr * 64 + fr, col0 = u.pn * 256 + wc * 32 + 8 * fq;
#pragma unroll
        for (int ai = 0; ai < 2; ++ai)
#pragma unroll
            for (int m = 0; m < 4; ++m) { const size_t row = (size_t)(row0 + ai * 128 + m * 16);
#pragma unroll
                for (int bj = 0; bj < 2; ++bj) { const u32x4 g = *(const u32x4*)(G + row * 2048 + PASS * 1024 + col0 + bj * 128); bf16_t* op = MRG + row * 1024 + col0 + bj * 128;
                    const f32x4 v0 = acc[ai][bj][m][0], v1 = acc[ai][bj][m][1];
                    float r0 = bflo(g.x) * v0[0], r1 = bfhi(g.x) * v0[1], r2 = bflo(g.y) * v0[2], r3 = bfhi(g.y) * v0[3], r4 = bflo(g.z) * v1[0], r5 = bfhi(g.z) * v1[1], r6 = bflo(g.w) * v1[2], r7 = bfhi(g.w) * v1[3];
                    if (PASS) { const u32x4 o = *(const u32x4*)op; r0 += bflo(o.x); r1 += bfhi(o.x); r2 += bflo(o.y); r3 += bfhi(o.y); r4 += bflo(o.z); r5 += bfhi(o.z); r6 += bflo(o.w); r7 += bfhi(o.w); }
                    u32x4 w; w.x = pk2(r0, r1); w.y = pk2(r2, r3); w.z = pk2(r4, r5); w.w = pk2(r6, r7);
                    *(u32x4*)op = w; } }
    }
};
__device__ __forceinline__ void phase_mod(const Args& a, LAS unsigned char* lds, float* MOD) {
    LAS float* sc = (LAS float*)lds; LAS float* part = sc + 17 * 1024;
    const int tid = opaque_tid();
    const float* c = INP(1); const float* cc = INP(3);
    for (int i = tid; i < 17 * 1024; i += NT) { const float v = i < 16 * 1024 ? c[i] : cc[i - 16 * 1024]; sc[i] = siluf_(v); }
    __syncthreads();
    const int col = tid & 63, ks = tid >> 6;
    for (int item = blockIdx.x; item < 288; item += gridDim.x) {
        const int l = item / 144, n0 = (item % 144) * 64;
        const float* W = INP(4) + (size_t)l * 1024 * 9216 + n0 + col;
        float acc[17];
#pragma unroll
        for (int r = 0; r < 17; ++r) acc[r] = 0.f;
        for (int k0 = ks * 128; k0 < ks * 128 + 128; k0 += 16) { float w[16];
#pragma unroll
            for (int u = 0; u < 16; ++u) w[u] = W[(size_t)(k0 + u) * 9216];
#pragma unroll
            for (int u = 0; u < 16; ++u)
#pragma unroll
                for (int r = 0; r < 17; ++r) acc[r] += sc[r * 1024 + k0 + u] * w[u]; }
#pragma unroll
        for (int r = 0; r < 17; ++r) part[(ks * 17 + r) * 64 + col] = acc[r];
        __syncthreads();
        for (int o = tid; o < 17 * 64; o += NT) { const int r = o >> 6, cl = o & 63; float s = INP(5)[l * 9216 + n0 + cl];
#pragma unroll
            for (int q = 0; q < 8; ++q) s += part[(q * 17 + r) * 64 + cl];
            MOD[(size_t)(l * 17 + r) * 9216 + n0 + cl] = s; }
        __syncthreads();
    }
}

__device__ __forceinline__ int map_col(int type, int dn0) {
    if (type == 0) return dn0;
    if (type == 1) { const int tile = dn0 >> 8, w = dn0 & 255; return w < 128 ? tile * 128 + w : DFF + tile * 128 + (w - 128); }
    if (dn0 < 2048) return dn0;
    if (dn0 < 2560) return 2080 + (dn0 - 2048);
    if (dn0 < 4608) return 2592 + (dn0 - 2560);
    if (dn0 < 4640) return 2048 + (dn0 - 4608);
    return -1;
}
__device__ __forceinline__ void conv_matrix(const float* W, int K, int Nsrc, int Ndst, bf16_t* WT, int type, LAS float* scr, int gw, int NGW, int lane) {
    const int nblk = Ndst / 32, nitems = (K / 64) * nblk;
    for (int item = gw; item < nitems; item += NGW) {
        const int kb = item / nblk, nb = item % nblk, k0 = 64 * kb, dn0 = 32 * nb, sn0 = map_col(type, dn0);
        if (sn0 >= 0) {
            float wv[32];
#pragma unroll
            for (int i = 0; i < 32; ++i) wv[i] = W[(size_t)(k0 + 2 * i + (lane >> 5)) * Nsrc + sn0 + (lane & 31)];
#pragma unroll
            for (int i = 0; i < 32; ++i) scr[(2 * i + (lane >> 5)) * 33 + (lane & 31)] = wv[i];
        } else {
#pragma unroll 8
            for (int i = 0; i < 32; ++i) { const int kk = 2 * i + (lane >> 5); scr[kk * 33 + (lane & 31)] = 0.f; }
        }
        LDS_WAIT();
        const int c = lane & 7;
#pragma unroll
        for (int j = 0; j < 4; ++j) { const int n = (lane >> 3) + 8 * j; const LAS float* s = scr + (8 * c) * 33 + n;
            u32x4 o; o.x = pk2(s[0 * 33], s[1 * 33]); o.y = pk2(s[2 * 33], s[3 * 33]); o.z = pk2(s[4 * 33], s[5 * 33]); o.w = pk2(s[6 * 33], s[7 * 33]);
            *(u32x4*)(WT + (size_t)(dn0 + n) * K + k0 + 8 * c) = o; }
        LDS_WAIT();
    }
}
__device__ __forceinline__ void phase_convert_part(const Args& a, int l, LAS unsigned char* lds, int part, int blk, int nblk) {
    const int tid = opaque_tid(), lane = tid & 63, wave = tid >> 6;
    LAS float* scr = (LAS float*)(lds + wave * 16384);
    const int gw = blk * 8 + wave, NGW = nblk * 8;
    if (part == 0) {
        conv_matrix(INP(7) + (size_t)l * D * 2 * DFF, D, 2 * DFF, 2 * DFF, (bf16_t*)WSO(WS_W1A), 1, scr, gw, NGW, lane);
        conv_matrix(INP(8) + (size_t)l * DFF * D, DFF, D, D, (bf16_t*)WSO(WS_W1B), 0, scr, gw, NGW, lane);
        conv_matrix(INP(10) + (size_t)l * D * 4640, D, 4640, NWIN, (bf16_t*)WSO(WS_WIN), 2, scr, gw, NGW, lane);
    } else {
        conv_matrix(INP(19) + (size_t)l * 512 * 512, 512, 512, 512, (bf16_t*)WSO(WS_WGLU), 0, scr, gw, NGW, lane);
        conv_matrix(INP(25) + (size_t)l * 512 * D, 512, D, D, (bf16_t*)WSO(WS_WPA), 0, scr, gw, NGW, lane);
        conv_matrix(INP(26) + (size_t)l * 512 * D, 512, D, D, (bf16_t*)WSO(WS_WPB), 0, scr, gw, NGW, lane);
        conv_matrix(INP(27) + (size_t)l * D * D, D, D, D, (bf16_t*)WSO(WS_WO), 0, scr, gw, NGW, lane);
        conv_matrix(INP(29) + (size_t)l * D * 2 * DFF, D, 2 * DFF, 2 * DFF, (bf16_t*)WSO(WS_W2A), 1, scr, gw, NGW, lane);
        conv_matrix(INP(30) + (size_t)l * DFF * D, DFF, D, D, (bf16_t*)WSO(WS_W2B), 0, scr, gw, NGW, lane);
    }
}

__device__ __forceinline__ void phase_norm_range(const float* src_lat, const float* src_ctx, const float* nw, const float* modl, int shift_idx, int scale_idx, bf16_t* XN, int r_begin, int r_end, int blk, int nblk) {
    const int tid = opaque_tid(), lane = tid & 63, wave = tid >> 6;
    const int gw = blk * 8 + wave, NGW = nblk * 8;
    for (int rp = (r_begin >> 2) + gw; rp < (r_end >> 2); rp += NGW) {
        f32x4 v[4][4]; float ss[4] = {0.f, 0.f, 0.f, 0.f};
        const int row0 = 4 * rp; const bool lat = row0 < ML;
        const float* xr = lat ? src_lat + (size_t)row0 * D : src_ctx + (size_t)(row0 - ML) * D; const int b = lat ? (row0 >> 11) : 16;
#pragma unroll
        for (int u = 0; u < 4; ++u)
#pragma unroll
            for (int j = 0; j < 4; ++j) v[u][j] = *(const f32x4*)(xr + u * D + lane * 4 + 256 * j);
#pragma unroll
        for (int u = 0; u < 4; ++u)
#pragma unroll
            for (int j = 0; j < 4; ++j) ss[u] += (v[u][j].x * v[u][j].x + v[u][j].y * v[u][j].y) + (v[u][j].z * v[u][j].z + v[u][j].w * v[u][j].w);
        float rr[4];
#pragma unroll
        for (int u = 0; u < 4; ++u) rr[u] = rsqrtf(wave_sum(ss[u]) * (1.0f / D) + EPS);
        const float* sh = modl + (size_t)b * 9216 + shift_idx * 1024; const float* scl = modl + (size_t)b * 9216 + scale_idx * 1024;
#pragma unroll
        for (int j = 0; j < 4; ++j) { const int col = lane * 4 + 256 * j;
            const f32x4 w = *(const f32x4*)(nw + col), s1 = *(const f32x4*)(scl + col), s0 = *(const f32x4*)(sh + col);
            const f32x4 g = w * (s1 + 1.0f);
#pragma unroll
            for (int u = 0; u < 4; ++u) { const f32x4 y = v[u][j] * rr[u] * g + s0; u32x2 o; o.x = pk2(y.x, y.y); o.y = pk2(y.z, y.w); *(u32x2*)(XN + (size_t)(row0 + u) * D + col) = o; } }
    }
}
__device__ __forceinline__ void phase_norm(const float* src_lat, const float* src_ctx, const float* nw, const float* modl, int shift_idx, int scale_idx, bf16_t* XN, int M) {
    phase_norm_range(src_lat, src_ctx, nw, modl, shift_idx, scale_idx, XN, 0, M, (int)blockIdx.x, (int)gridDim.x);
}
__device__ __forceinline__ void phase_final(float* h, const float* nw) {
    const int tid = opaque_tid(), lane = tid & 63, wave = tid >> 6;
    const int gw = blockIdx.x * 8 + wave, NGW = gridDim.x * 8;
    for (int rp = gw; rp < (ML >> 1); rp += NGW) {
        float* xr = h + (size_t)(2 * rp) * D;
        f32x4 v[2][4]; float ss[2] = {0.f, 0.f};
#pragma unroll
        for (int u = 0; u < 2; ++u)
#pragma unroll
            for (int j = 0; j < 4; ++j) v[u][j] = *(const f32x4*)(xr + u * D + lane * 4 + 256 * j);
#pragma unroll
        for (int u = 0; u < 2; ++u)
#pragma unroll
            for (int j = 0; j < 4; ++j) ss[u] += (v[u][j].x * v[u][j].x + v[u][j].y * v[u][j].y) + (v[u][j].z * v[u][j].z + v[u][j].w * v[u][j].w);
        const float r0 = rsqrtf(wave_sum(ss[0]) * (1.0f / D) + EPS), r1 = rsqrtf(wave_sum(ss[1]) * (1.0f / D) + EPS);
#pragma unroll
        for (int j = 0; j < 4; ++j) { const int col = lane * 4 + 256 * j; const f32x4 w = *(const f32x4*)(nw + col);
            *(f32x4*)(xr + col) = v[0][j] * r0 * w; *(f32x4*)(xr + D + col) = v[1][j] * r1 * w; }
    }
}
__device__ __forceinline__ void phase_s5_combine(bf16_t* Y0, const bf16_t* Y1, int M) {
    const size_t nvec = (size_t)M * 512 / 8, stride = (size_t)gridDim.x * NT;
    for (size_t i = (size_t)blockIdx.x * NT + opaque_tid(); i < nvec; i += 4 * stride) {
        u32x4 p[4], q[4];
#pragma unroll
        for (int u = 0; u < 4; ++u) { const size_t k = i + u * stride; if (k < nvec) { p[u] = *(const u32x4*)(Y0 + k * 8); q[u] = *(const u32x4*)(Y1 + k * 8); } }
#pragma unroll
        for (int u = 0; u < 4; ++u) { const size_t k = i + u * stride; if (k < nvec) { u32x4 w;
            w.x = pk2(gelu_tanh(bflo(p[u].x) + bflo(q[u].x)), gelu_tanh(bfhi(p[u].x) + bfhi(q[u].x)));
            w.y = pk2(gelu_tanh(bflo(p[u].y) + bflo(q[u].y)), gelu_tanh(bfhi(p[u].y) + bfhi(q[u].y)));
            w.z = pk2(gelu_tanh(bflo(p[u].z) + bflo(q[u].z)), gelu_tanh(bfhi(p[u].z) + bfhi(q[u].z)));
            w.w = pk2(gelu_tanh(bflo(p[u].w) + bflo(q[u].w)), gelu_tanh(bfhi(p[u].w) + bfhi(q[u].w)));
            *(u32x4*)(Y0 + k * 8) = w; } }
    }
}
__device__ __forceinline__ void phase_gdn_finish(bf16_t* O0, const bf16_t* O1, const bf16_t* Z, const float* dnw, int M, int blk, int nblk) {
    const int tid = opaque_tid(), lane = tid & 63, wave = tid >> 6;
    const int gw = blk * 8 + wave, NGW = nblk * 8;
    const f32x4 w0 = *(const f32x4*)(dnw + (lane & 7) * 8), w1 = *(const f32x4*)(dnw + (lane & 7) * 8 + 4);
    const float ww[8] = { w0.x, w0.y, w0.z, w0.w, w1.x, w1.y, w1.z, w1.w };
    for (int rp = gw; rp < (M >> 2); rp += NGW) {
        u32x4 p[4], q[4], z[4];
#pragma unroll
        for (int u = 0; u < 4; ++u) { const size_t off = (size_t)(4 * rp + u) * 512 + lane * 8; p[u] = *(const u32x4*)(O0 + off); q[u] = *(const u32x4*)(O1 + off); z[u] = *(const u32x4*)(Z + off); }
#pragma unroll
        for (int u = 0; u < 4; ++u) { const size_t off = (size_t)(4 * rp + u) * 512 + lane * 8;
            float o[8] = { bflo(p[u].x) + bflo(q[u].x), bfhi(p[u].x) + bfhi(q[u].x), bflo(p[u].y) + bflo(q[u].y), bfhi(p[u].y) + bfhi(q[u].y), bflo(p[u].z) + bflo(q[u].z), bfhi(p[u].z) + bfhi(q[u].z), bflo(p[u].w) + bflo(q[u].w), bfhi(p[u].w) + bfhi(q[u].w) };
            float ss = 0.f;
#pragma unroll
            for (int j = 0; j < 8; ++j) ss += o[j] * o[j];
            ss += __shfl_xor(ss, 1); ss += __shfl_xor(ss, 2); ss += __shfl_xor(ss, 4);
            const float rn = rsqrtf(ss * (1.0f / 64.0f) + EPS);
            const float zz[8] = { bflo(z[u].x), bfhi(z[u].x), bflo(z[u].y), bfhi(z[u].y), bflo(z[u].z), bfhi(z[u].z), bflo(z[u].w), bfhi(z[u].w) };
            float y[8];
#pragma unroll
            for (int j = 0; j < 8; ++j) y[j] = o[j] * rn * ww[j] * siluf_(zz[j]);
            u32x4 w; w.x = pk2(y[0], y[1]); w.y = pk2(y[2], y[3]); w.z = pk2(y[4], y[5]); w.w = pk2(y[6], y[7]);
            *(u32x4*)(O0 + off) = w; }
    }
}
__device__ __forceinline__ int s5_row(int b, int dir, int n) {
    if (n < CTXL) { const int s = dir ? (CTXL - 1 - n) : n; return ML + b * CTXL + s; }
    const int t = n - CTXL; return b * SEQ + (dir ? (SEQ - 1 - t) : t);
}
#define MFMA16(A_, B_, C_) __builtin_amdgcn_mfma_f32_16x16x32_bf16((A_), (B_), (C_), 0, 0, 0)
__device__ __forceinline__ void phase_s5(const Args& a, int l, LAS unsigned char* lds, const bf16_t* U, bf16_t* Y0, bf16_t* Y1) {
    const int tid = opaque_tid(), lane = tid & 63, wave = __builtin_amdgcn_readfirstlane(tid >> 6), fr = lane & 15, fq = lane >> 4;
    LAS unsigned char* PB0 = lds + (wave >> 1) * 34816; LAS unsigned char* EX = lds + 139264 + wave * 1024; LAS unsigned char* YB = lds + 147456 + wave * 1024;
    const float* lam_re = INP(11); const float* lam_im = INP(12); const float* log_dt = INP(13); const float* b_re = INP(14); const float* b_im = INP(15);
    const float* c_re = INP(16); const float* c_im = INP(17); const float* s5d = INP(18);
    for (int task = blockIdx.x * 8 + wave; task < 2048; task += gridDim.x * 8) {
        const int b = task >> 7, g = (task >> 2) & 31, dir = (task >> 1) & 1, half = task & 1;
        const int pidx = (l * 2 + dir) * 32 + g;
        const float dt = expf(log_dt[pidx]);
        float are[2], aim[2], a8r[2], a8i[2]; bf16x8 Ybb[2][2];
#pragma unroll
        for (int nt = 0; nt < 2; ++nt) {
            const int p = 16 * (2 * half + nt) + fr;
            const float lr = lam_re[pidx * 64 + p], li = lam_im[pidx * 64 + p];
            const float mag = expf(lr * dt), ar = mag * cosf(li * dt), ai = mag * sinf(li * dt), den = lr * lr + li * li;
            const float fre = ((ar - 1.0f) * lr + ai * li) / den, fim = (ai * lr - (ar - 1.0f) * li) / den;
            are[nt] = ar; aim[nt] = ai;
            const float a2r = ar * ar - ai * ai, a2i = 2.0f * ar * ai, a4r = a2r * a2r - a2i * a2i, a4i = 2.0f * a2r * a2i;
            a8r[nt] = a4r * a4r - a4i * a4i; a8i[nt] = 2.0f * a4r * a4i;
            u32x4 wre = {0u, 0u, 0u, 0u}, wim = {0u, 0u, 0u, 0u};
            if (fq < 2) {
                const float* br = b_re + ((size_t)pidx * 64 + p) * 16 + 8 * fq; const float* bi = b_im + ((size_t)pidx * 64 + p) * 16 + 8 * fq;
                float re[8], im[8];
#pragma unroll
                for (int j = 0; j < 8; ++j) { re[j] = fre * br[j] - fim * bi[j]; im[j] = fre * bi[j] + fim * br[j]; }
                wre.x = pk2(re[0], re[1]); wre.y = pk2(re[2], re[3]); wre.z = pk2(re[4], re[5]); wre.w = pk2(re[6], re[7]);
                wim.x = pk2(im[0], im[1]); wim.y = pk2(im[2], im[3]); wim.z = pk2(im[4], im[5]); wim.w = pk2(im[6], im[7]);
            }
            Ybb[nt][0] = __builtin_bit_cast(bf16x8, wre); Ybb[nt][1] = __builtin_bit_cast(bf16x8, wim);
        }
        bf16x8 Yc[4];
#pragma unroll
        for (int ks = 0; ks < 4; ++ks) { const int pf = 4 * ks + fq; float v[8];
#pragma unroll
            for (int j = 0; j < 8; ++j) { const int nt = j >> 1, p = 16 * nt + pf; const size_t ci = ((size_t)pidx * 16 + fr) * 64 + p; v[j] = (j & 1) ? -c_im[ci] : c_re[ci]; }
            u32x4 w; w.x = pk2(v[0], v[1]); w.y = pk2(v[2], v[3]); w.z = pk2(v[4], v[5]); w.w = pk2(v[6], v[7]); Yc[ks] = __builtin_bit_cast(bf16x8, w); }
        const float dsk = s5d[l * 512 + g * 16 + fr];
        bf16_t* Yd = dir ? Y1 : Y0;
        const bool dskip = (dir == 0);
        float cyr[2] = {0.f, 0.f}, cyi[2] = {0.f, 0.f};
        bf16x8 Ydg;
        { float v[8];
#pragma unroll
          for (int j = 0; j < 8; ++j) v[j] = (fq < 2 && 8 * fq + j == fr) ? dsk : 0.f;
          u32x4 w; w.x = pk2(v[0], v[1]); w.y = pk2(v[2], v[3]); w.z = pk2(v[4], v[5]); w.w = pk2(v[6], v[7]); Ydg = __builtin_bit_cast(bf16x8, w); }
        float a16r[2], a16i[2];
#pragma unroll
        for (int nt = 0; nt < 2; ++nt) { a16r[nt] = a8r[nt] * a8r[nt] - a8i[nt] * a8i[nt]; a16i[nt] = 2.0f * a8r[nt] * a8i[nt]; }
        u32x4 nXu[4];
        const int sgn = dir ? -1 : 1;
        const int offU0 = sgn * ((fr >> 2) * 16 + (fr & 3)) * 512 + g * 16 + 8 * (fq & 1), dU = sgn * 4 * 512;
        const int offN0 = sgn * (32 * half + fr) * 512 + g * 16 + 8 * (fq & 1), offN1 = offN0 + sgn * 16 * 512;
        const int offY = sgn * (32 * half + (lane >> 1)) * 512 + g * 16 + 8 * (lane & 1);
#define S5_PREFETCH(N0) do { const bf16_t* Ub_ = U + (size_t)__builtin_amdgcn_readfirstlane(s5_row(b, dir, (N0))) * 512; \
            _Pragma("unroll") for (int m_ = 0; m_ < 4; ++m_) { nXu[m_] = (u32x4){0u, 0u, 0u, 0u}; if (fq < 2) nXu[m_] = *(const u32x4*)(Ub_ + offU0 + m_ * dU); } } while (0)
        S5_PREFETCH(0);
        for (int c = 0; c < 36; ++c) {
            const int n0 = 64 * c;
            LAS unsigned char* PB = PB0 + (c & 1) * 17408;
            bf16x8 Xu[4], Xn[2];
#pragma unroll
            for (int mt = 0; mt < 4; ++mt) Xu[mt] = __builtin_bit_cast(bf16x8, nXu[mt]);
            { u32x4 t0 = {0u, 0u, 0u, 0u}, t1 = t0;
              if (fq < 2 && dskip) { const bf16_t* Ub_ = U + (size_t)__builtin_amdgcn_readfirstlane(s5_row(b, dir, n0)) * 512; t0 = *(const u32x4*)(Ub_ + offN0); t1 = *(const u32x4*)(Ub_ + offN1); }
              Xn[0] = __builtin_bit_cast(bf16x8, t0); Xn[1] = __builtin_bit_cast(bf16x8, t1); }
            if (c + 1 < 36) S5_PREFETCH(n0 + 64);
            float Fre[2], Fim[2];
#pragma unroll
            for (int nt = 0; nt < 2; ++nt) {
                const float ar = are[nt], ai = aim[nt];
                f32x4 bu[4][2];
#pragma unroll
                for (int mt = 0; mt < 4; ++mt)
#pragma unroll
                    for (int ri = 0; ri < 2; ++ri) bu[mt][ri] = MFMA16(Xu[mt], Ybb[nt][ri], ((f32x4){0.f, 0.f, 0.f, 0.f}));
                float s_r = 0.f, s_i = 0.f;
#pragma unroll
                for (int tt = 0; tt < 16; ++tt) { const float br = bu[tt >> 2][0][tt & 3], bi = bu[tt >> 2][1][tt & 3];
                    const float nr = ar * s_r - ai * s_i + br, ni = ar * s_i + ai * s_r + bi; s_r = nr; s_i = ni; }
                Fre[nt] = s_r; Fim[nt] = s_i;
            }
            { const f32x4 w0 = {Fre[0], Fim[0], Fre[1], Fim[1]};
              *(LAS f32x4*)(EX + (fq * 16 + fr) * 16) = w0; }
            LDS_WAIT();
            float cinr[2], cini[2];
            { float Cr[2], Ci[2];
#pragma unroll
              for (int nt = 0; nt < 2; ++nt) { Cr[nt] = cyr[nt]; Ci[nt] = cyi[nt]; cinr[nt] = Cr[nt]; cini[nt] = Ci[nt]; }
#pragma unroll
              for (int q = 0; q < 4; ++q) { const f32x4 g0 = *(const LAS f32x4*)(EX + (q * 16 + fr) * 16);
                  const float Fr[2] = {g0.x, g0.z}, Fi[2] = {g0.y, g0.w};
#pragma unroll
                  for (int nt = 0; nt < 2; ++nt) { const float nCr = a16r[nt] * Cr[nt] - a16i[nt] * Ci[nt] + Fr[nt], nCi = a16r[nt] * Ci[nt] + a16i[nt] * Cr[nt] + Fi[nt]; Cr[nt] = nCr; Ci[nt] = nCi;
                      if (fq == q + 1) { cinr[nt] = nCr; cini[nt] = nCi; } } }
#pragma unroll
              for (int nt = 0; nt < 2; ++nt) { cyr[nt] = Cr[nt]; cyi[nt] = Ci[nt]; } }
            LDS_WAIT();
            asm volatile("" : "+v"(Xu[0]), "+v"(Xu[1]), "+v"(Xu[2]), "+v"(Xu[3]));
#pragma unroll
            for (int nt = 0; nt < 2; ++nt) {
                const float ar = are[nt], ai = aim[nt];
                f32x4 bu[4][2];
#pragma unroll
                for (int mt = 0; mt < 4; ++mt)
#pragma unroll
                    for (int ri = 0; ri < 2; ++ri) bu[mt][ri] = MFMA16(Xu[mt], Ybb[nt][ri], ((f32x4){0.f, 0.f, 0.f, 0.f}));
                float s_r = cinr[nt], s_i = cini[nt];
#pragma unroll
                for (int tt = 0; tt < 16; ++tt) { const float br = bu[tt >> 2][0][tt & 3], bi = bu[tt >> 2][1][tt & 3];
                    const float nr = ar * s_r - ai * s_i + br, ni = ar * s_i + ai * s_r + bi; s_r = nr; s_i = ni;
                    *(LAS unsigned*)(PB + (16 * fq + tt) * 272 + fr * 16 + (2 * half + nt) * 4) = pk2(nr, ni); }
            }
            LDS_WAIT(); __builtin_amdgcn_s_barrier(); asm volatile("" ::: "memory");
#pragma unroll
            for (int m2 = 0; m2 < 2; ++m2) { f32x4 y = {0.f, 0.f, 0.f, 0.f};
#pragma unroll
              for (int ks = 0; ks < 4; ++ks) { const bf16x8 Xs = *(const LAS bf16x8*)(PB + (32 * half + 16 * m2 + fr) * 272 + ks * 64 + fq * 16); y = MFMA16(Xs, Yc[ks], y); }
              if (dskip) y = MFMA16(Xn[m2], Ydg, y);
#pragma unroll
              for (int r = 0; r < 4; ++r) *(LAS bf16_t*)(YB + (16 * m2 + 4 * fq + r) * 32 + fr * 2) = f2bf(y[r]); }
            LDS_WAIT();
            { const u32x4 yv = *(const LAS u32x4*)(YB + lane * 16);
              *(u32x4*)(Yd + (size_t)__builtin_amdgcn_readfirstlane(s5_row(b, dir, n0)) * 512 + offY) = yv; }
            LDS_WAIT();
        }
#undef S5_PREFETCH
    }
}
#ifndef NSUBREP
#define NSUBREP 1
#endif
#ifndef NS12REP
#define NS12REP 1
#endif
constexpr int RS = 144, L_KB = 0, L_KN = 9216, L_QN = 18432, L_KE = 27648, L_QD = 36864, L_KDT = 46080, L_ST = 55296, L_RT = 64512, L_VB = 73728,
              L_RAW = 91136, L_LF = 91136, L_LB = 108544, L_T11T = 113152, L_MT = 117760, L_AT = 122368, L_CW = 131584, L_GC = 135424, L_TB = L_KB, L_VNT = L_QN;
__device__ __forceinline__ f32x4 tile_mma(const LAS unsigned char* X, int xr0, const LAS unsigned char* Y, int yr0, int fr, int fq, f32x4 acc) {
#pragma unroll
    for (int ks = 0; ks < 2; ++ks) {
        const bf16x8 xa = *(const LAS bf16x8*)(X + (xr0 + fr) * RS + ks * 64 + fq * 16);
        const bf16x8 yb = *(const LAS bf16x8*)(Y + (yr0 + fr) * RS + ks * 64 + fq * 16);
        acc = MFMA16(xa, yb, acc);
    }
    return acc;
}
__device__ __forceinline__ int gdn_row(int b, bool isctx, int s) { return isctx ? (ML + b * CTXL + s) : (b * SEQ + (s & 31) * 64 + (s >> 5)); }

#define GBAR() do { asm volatile("s_waitcnt lgkmcnt(0)" ::: "memory"); __builtin_amdgcn_s_barrier(); asm volatile("" ::: "memory"); } while (0)
__device__ __forceinline__ f32x4 tile_mma1(const LAS unsigned char* X, int xoff, const LAS unsigned char* Y, int yoff, f32x4 acc) {
    const bf16x8 xa = *(const LAS bf16x8*)(X + xoff); const bf16x8 yb = *(const LAS bf16x8*)(Y + yoff); return MFMA16(xa, yb, acc);
}
__device__ __forceinline__ void phase_gdn(const Args& a, int l, LAS unsigned char* lds, const bf16_t* QKV, const float* AB, bf16_t* O0, bf16_t* O1) {
    const int tid = opaque_tid(), lane = tid & 63, wave = __builtin_amdgcn_readfirstlane(tid >> 6), fr = lane & 15, fq = lane >> 4;
    LAS float* CW = (LAS float*)(lds + L_CW); LAS float* GC0 = (LAS float*)(lds + L_GC);
    LAS float* VB = (LAS float*)(lds + L_VB); LAS float* LF = (LAS float*)(lds + L_LF);
    for (int task = blockIdx.x; task < 256; task += gridDim.x) {
        const int b = task >> 4, h = (task >> 1) & 7, dir = task & 1;
        bf16_t* Od = dir ? O1 : O0;
        __syncthreads();
        for (int i = tid; i < 5 * 192; i += NT) { const int j = i / 192, ch = i % 192, sel = ch >> 6, cc = ch & 63; CW[i] = INP(21)[(size_t)(l * 5 + j) * 1536 + sel * 512 + 64 * h + cc]; }
        for (int i = tid; i < 64 * RS / 4; i += NT) ((LAS unsigned*)(lds + L_ST))[i] = 0u;
        const float alog = -expf(INP(22)[(l * 2 + dir) * 8 + h]), dtb = INP(23)[(l * 2 + dir) * 8 + h];
        f32x4 Sreg[2] = {{0.f, 0.f, 0.f, 0.f}, {0.f, 0.f, 0.f, 0.f}};
        u32x4 pre[4]; float pa = 0.f, pb = 0.f;
#define GDN_PREFETCH(CC) do { const bool ic_ = (CC) < 4; const int Lq_ = ic_ ? CTXL : SEQ, c_ = ic_ ? (CC) : (CC) - 4; const int sl_ = dir ? (Lq_ - 64 * (c_ + 1)) : 64 * c_; \
            _Pragma("unroll") for (int q_ = 0; q_ < 4; ++q_) { const int it_ = tid + q_ * NT; pre[q_] = (u32x4){0u, 0u, 0u, 0u}; \
                if (it_ < 68 * 24) { const int rr_ = it_ / 24, v_ = it_ % 24, sel_ = v_ >> 3, c8_ = v_ & 7, s_ = sl_ - 2 + rr_; \
                    if (s_ >= 0 && s_ < Lq_) pre[q_] = *(const u32x4*)(QKV + (size_t)gdn_row(b, ic_, s_) * 1536 + sel_ * 512 + 64 * h + 8 * c8_); } } \
            if (wave == 7) { const int s_ = dir ? (sl_ + 63 - lane) : (sl_ + lane); const size_t ro_ = (size_t)gdn_row(b, ic_, s_) * 32; pa = AB[ro_ + dir * 8 + h]; pb = AB[ro_ + 16 + dir * 8 + h]; } } while (0)
#define GDN_GATES(CN) do { LAS float* Gn_ = GC0 + ((CN) & 1) * 256; const float av_ = pa + dtb; const float sp_ = av_ > 20.f ? av_ : log1pf(expf(av_)); float gc_ = alog * sp_; \
            _Pragma("unroll") for (int o_ = 1; o_ < 64; o_ <<= 1) { const float t_ = __shfl_up(gc_, o_); if (lane >= o_) gc_ += t_; } \
            const float g63_ = __shfl(gc_, 63); Gn_[lane] = gc_; Gn_[64 + lane] = sigmoidf_(pb); Gn_[128 + lane] = expf(gc_); Gn_[192 + lane] = expf(g63_ - gc_); } while (0)
#define GDN_STAGE(CN) do { \
            _Pragma("unroll") for (int q_ = 0; q_ < 4; ++q_) { const int it_ = tid + q_ * NT; if (it_ < 68 * 24) *(LAS u32x4*)(lds + L_RAW + (it_ / 24) * 384 + (it_ % 24) * 16) = pre[q_]; } \
            if ((CN) + 1 < 36) GDN_PREFETCH((CN) + 1); } while (0)
        GDN_PREFETCH(0);
        if (wave == 7) GDN_GATES(0);
        GDN_STAGE(0);
        GBAR();
        for (int cc = 0; cc < 36; ++cc) {
            const bool isctx = cc < 4; const int Lq = isctx ? CTXL : SEQ, c = isctx ? cc : cc - 4;
            const int s_lo = dir ? (Lq - 64 * (c + 1)) : 64 * c;
            LAS float* GC = GC0 + (cc & 1) * 256; LAS float* BT = GC + 64; LAS float* EG = GC + 128; LAS float* EKD = GC + 192;
#pragma unroll
            for (int x2 = 0; x2 < 2; ++x2) { const int td = 2 * (wave >> 2) + x2, te = wave & 3; u32x2 o; o.x = pk2(Sreg[x2][0], Sreg[x2][1]); o.y = pk2(Sreg[x2][2], Sreg[x2][3]);
                *(LAS u32x2*)(lds + L_ST + (16 * te + fr) * RS + (16 * td + 4 * fq) * 2) = o; }
            for (int itc = 0; itc < 3; ++itc) {
                const int it = tid + itc * NT, v8 = it & 7, ps = it >> 3, i = ps / 3, sel = ps - 3 * i, ch0 = sel * 64 + v8 * 8;
                const int rc = (dir ? (63 - i) : i) + 2;
                float acc[8];
#pragma unroll
                for (int k = 0; k < 8; ++k) acc[k] = 0.f;
#pragma unroll
                for (int j = 0; j < 5; ++j) { const u32x4 x = *(const LAS u32x4*)(lds + L_RAW + (rc + j - 2) * 384 + ch0 * 2);
                    const f32x4 w0 = *(const LAS f32x4*)(CW + j * 192 + ch0), w1 = *(const LAS f32x4*)(CW + j * 192 + ch0 + 4);
                    acc[0] += w0.x * bflo(x.x); acc[1] += w0.y * bfhi(x.x); acc[2] += w0.z * bflo(x.y); acc[3] += w0.w * bfhi(x.y);
                    acc[4] += w1.x * bflo(x.z); acc[5] += w1.y * bfhi(x.z); acc[6] += w1.z * bflo(x.w); acc[7] += w1.w * bfhi(x.w); }
                float ss = 0.f;
#pragma unroll
                for (int k = 0; k < 8; ++k) { acc[k] = siluf_(acc[k]); ss += acc[k] * acc[k]; }
                ss += __shfl_xor(ss, 1); ss += __shfl_xor(ss, 2); ss += __shfl_xor(ss, 4);
                const float rn = rsqrtf(ss + EPS);
                const float bt = BT[i], eg = EG[i], ekd = EKD[i];
                if (sel == 0) {
                    const float s0 = rn * 0.125f, s1 = s0 * eg; u32x4 w0, w1;
                    w0.x = pk2(acc[0] * s0, acc[1] * s0); w0.y = pk2(acc[2] * s0, acc[3] * s0); w0.z = pk2(acc[4] * s0, acc[5] * s0); w0.w = pk2(acc[6] * s0, acc[7] * s0);
                    w1.x = pk2(acc[0] * s1, acc[1] * s1); w1.y = pk2(acc[2] * s1, acc[3] * s1); w1.z = pk2(acc[4] * s1, acc[5] * s1); w1.w = pk2(acc[6] * s1, acc[7] * s1);
                    *(LAS u32x4*)(lds + L_QN + i * RS + v8 * 16) = w0; *(LAS u32x4*)(lds + L_QD + i * RS + v8 * 16) = w1;
                } else if (sel == 1) {
                    const float s0 = rn, s1 = rn * bt, s2 = rn * eg, s3 = rn * ekd; u32x4 w0, w1, w2;
                    w0.x = pk2(acc[0] * s0, acc[1] * s0); w0.y = pk2(acc[2] * s0, acc[3] * s0); w0.z = pk2(acc[4] * s0, acc[5] * s0); w0.w = pk2(acc[6] * s0, acc[7] * s0);
                    w1.x = pk2(acc[0] * s1, acc[1] * s1); w1.y = pk2(acc[2] * s1, acc[3] * s1); w1.z = pk2(acc[4] * s1, acc[5] * s1); w1.w = pk2(acc[6] * s1, acc[7] * s1);
                    w2.x = pk2(acc[0] * s2, acc[1] * s2); w2.y = pk2(acc[2] * s2, acc[3] * s2); w2.z = pk2(acc[4] * s2, acc[5] * s2); w2.w = pk2(acc[6] * s2, acc[7] * s2);
                    *(LAS u32x4*)(lds + L_KN + i * RS + v8 * 16) = w0; *(LAS u32x4*)(lds + L_KB + i * RS + v8 * 16) = w1; *(LAS u32x4*)(lds + L_KE + i * RS + v8 * 16) = w2;
#pragma unroll
                    for (int k = 0; k < 8; ++k) *(LAS bf16_t*)(lds + L_KDT + (v8 * 8 + k) * RS + i * 2) = f2bf(acc[k] * s3);
                } else {
                    f32x4 w0 = {acc[0] * bt, acc[1] * bt, acc[2] * bt, acc[3] * bt}, w1 = {acc[4] * bt, acc[5] * bt, acc[6] * bt, acc[7] * bt};
                    *(LAS f32x4*)(VB + i * 68 + v8 * 8) = w0; *(LAS f32x4*)(VB + i * 68 + v8 * 8 + 4) = w1;
                }
            }
            GBAR();
            for (int q = wave; q < 10; q += 8) {
                const int ti = q < 1 ? 0 : q < 3 ? 1 : q < 6 ? 2 : 3; const int tj = q - (ti * (ti + 1)) / 2;
                const f32x4 w = tile_mma(lds + L_KB, 16 * ti, lds + L_KN, 16 * tj, fr, fq, (f32x4){0.f, 0.f, 0.f, 0.f});
                const int j = 16 * tj + fr; const float gj = GC[j];
#pragma unroll
                for (int r = 0; r < 4; ++r) { const int i = 16 * ti + 4 * fq + r; const float v = (i > j) ? w[r] * __expf(GC[i] - gj) : 0.f; LF[i * 68 + j] = v;
                    if (ti >= 2 && tj < 2) *(LAS bf16_t*)(lds + L_LB + (i - 32) * RS + j * 2) = f2bf(v); }
            }
            GBAR();
            if (wave == 0) {
                __builtin_amdgcn_s_setprio(3);
                int ln = lane; asm volatile("" : "+v"(ln));
                const int hb = ln >> 5, cl = ln & 31;
                const LAS float* Lb = LF + (32 * hb) * 68 + 32 * hb;
                float x[32];
                f32x4 Lr[2][8];
                Lr[1][0] = *(const LAS f32x4*)(Lb + 1 * 68);
#pragma unroll
                for (int i = 0; i < 32; ++i) {
                    asm volatile("" ::: "memory");
                    if (i >= 1 && i + 1 < 32) {
#pragma unroll
                        for (int v = 0; v < (i + 1 + 3) / 4; ++v) Lr[(i + 1) & 1][v] = *(const LAS f32x4*)(Lb + (i + 1) * 68 + 4 * v);
                    }
                    float a0 = (float)(1u - __builtin_elementwise_min((unsigned)(i ^ cl), 1u)), a1 = 0.f, a2 = 0.f, a3 = 0.f;
#pragma unroll
                    for (int v = 0; v < (i + 3) / 4; ++v) { const f32x4 lv = Lr[i & 1][v];
                        if (4 * v + 0 < i) a0 -= lv.x * x[4 * v + 0];
                        if (4 * v + 1 < i) a1 -= lv.y * x[4 * v + 1];
                        if (4 * v + 2 < i) a2 -= lv.z * x[4 * v + 2];
                        if (4 * v + 3 < i) a3 -= lv.w * x[4 * v + 3]; }
                    x[i] = (a0 + a1) + (a2 + a3);
                    *(LAS bf16_t*)(lds + L_TB + (32 * hb + i) * RS + (32 * hb + cl) * 2) = f2bf(x[i]);
                }
                if (hb == 0) {
#pragma unroll
                    for (int v = 0; v < 4; ++v) { u32x4 w; w.x = pk2(x[8 * v], x[8 * v + 1]); w.y = pk2(x[8 * v + 2], x[8 * v + 3]); w.z = pk2(x[8 * v + 4], x[8 * v + 5]); w.w = pk2(x[8 * v + 6], x[8 * v + 7]);
                        *(LAS u32x4*)(lds + L_T11T + cl * RS + v * 16) = w; }
                }
                LDS_WAIT();
#pragma unroll
                for (int t = 0; t < 4; ++t) { const int it = t >> 1, ct = t & 1;
                    const f32x4 m = tile_mma1(lds + L_LB, (16 * it + fr) * RS + fq * 16, lds + L_T11T, (16 * ct + fr) * RS + fq * 16, (f32x4){0.f, 0.f, 0.f, 0.f});
                    u32x2 o; o.x = pk2(m[0], m[1]); o.y = pk2(m[2], m[3]);
                    *(LAS u32x2*)(lds + L_MT + (16 * ct + fr) * RS + (16 * it + 4 * fq) * 2) = o; }
                LDS_WAIT();
#pragma unroll
                for (int t = 0; t < 4; ++t) { const int it = t >> 1, ct = t & 1;
                    const f32x4 m = tile_mma1(lds + L_TB, (32 + 16 * it + fr) * RS + 64 + fq * 16, lds + L_MT, (16 * ct + fr) * RS + fq * 16, (f32x4){0.f, 0.f, 0.f, 0.f});
#pragma unroll
                    for (int r = 0; r < 4; ++r) *(LAS bf16_t*)(lds + L_TB + (32 + 16 * it + 4 * fq + r) * RS + (16 * ct + fr) * 2) = f2bf(-m[r]); }
                __builtin_amdgcn_s_setprio(0);
            } else {
                const int ord = wave <= 3 ? wave - 1 : (wave == 6 ? 3 : (wave == 7 ? 6 : wave));
                for (int idx = ord; idx < 32; idx += 7) {
                    if (idx < 16) {
                        const int ti = idx >> 2, te = idx & 3;
                        const f32x4 w = tile_mma(lds + L_KE, 16 * ti, lds + L_ST, 16 * te, fr, fq, (f32x4){0.f, 0.f, 0.f, 0.f});
                        float rv[4];
#pragma unroll
                        for (int r = 0; r < 4; ++r) { const int i = 16 * ti + 4 * fq + r; rv[r] = VB[i * 68 + 16 * te + fr] - BT[i] * w[r]; }
                        u32x2 o; o.x = pk2(rv[0], rv[1]); o.y = pk2(rv[2], rv[3]);
                        *(LAS u32x2*)(lds + L_RT + (16 * te + fr) * RS + (16 * ti + 4 * fq) * 2) = o;
                    } else {
                        const int ti = (idx - 16) >> 2, tj = (idx - 16) & 3;
                        f32x4 w = {0.f, 0.f, 0.f, 0.f};
                        if (tj <= ti) w = tile_mma(lds + L_QN, 16 * ti, lds + L_KN, 16 * tj, fr, fq, w);
                        const int j = 16 * tj + fr; const float gj = GC[j];
#pragma unroll
                        for (int r = 0; r < 4; ++r) { const int i = 16 * ti + 4 * fq + r; const float v = (i >= j) ? w[r] * __expf(GC[i] - gj) : 0.f; *(LAS bf16_t*)(lds + L_AT + i * RS + j * 2) = f2bf(v); }
                    }
                }
                if (wave == 7 && cc + 1 < 36) GDN_GATES(cc + 1);
            }
            GBAR();
            {
                const int te = wave & 3, hb2 = wave >> 2;
#pragma unroll
                for (int ti = 0; ti < 4; ++ti) {
                    f32x4 w = tile_mma1(lds + L_TB, (16 * ti + fr) * RS + fq * 16, lds + L_RT, (16 * te + fr) * RS + fq * 16, (f32x4){0.f, 0.f, 0.f, 0.f});
                    if (ti >= 2) w = tile_mma1(lds + L_TB, (16 * ti + fr) * RS + 64 + fq * 16, lds + L_RT, (16 * te + fr) * RS + 64 + fq * 16, w);
                    u32x2 o; o.x = pk2(w[0], w[1]); o.y = pk2(w[2], w[3]);
                    *(LAS u32x2*)(lds + L_VNT + (16 * te + fr) * RS + (16 * ti + 4 * fq) * 2) = o; }
                LDS_WAIT();
                const float gl = EG[63];
#pragma unroll
                for (int x2 = 0; x2 < 2; ++x2) { const int ti = 2 * hb2 + x2;
                    const f32x4 p1 = tile_mma(lds + L_QD, 16 * ti, lds + L_ST, 16 * te, fr, fq, (f32x4){0.f, 0.f, 0.f, 0.f});
                    const f32x4 o = tile_mma(lds + L_AT, 16 * ti, lds + L_VNT, 16 * te, fr, fq, p1);
#pragma unroll
                    for (int r = 0; r < 4; ++r) { const int i = 16 * ti + 4 * fq + r; const int s = dir ? (s_lo + 63 - i) : (s_lo + i);
                        Od[(size_t)gdn_row(b, isctx, s) * 512 + 64 * h + 16 * te + fr] = f2bf(o[r]); }
                    Sreg[x2] = tile_mma(lds + L_KDT, 16 * ti, lds + L_VNT, 16 * te, fr, fq, Sreg[x2] * gl); }
            }
            if (cc + 1 < 36) GDN_STAGE(cc + 1);
            GBAR();
        }
#undef GDN_STAGE
#undef GDN_GATES
#undef GDN_PREFETCH
    }
}
#ifndef GALIGN
#define GALIGN true
#endif
#ifndef GSP2
#define GSP2 true
#endif

#define XB_TMO      128
#define XB_XCNT(j)  (256  + 64 * (j))
#define XB_XSUB(j)  (1280 + 64 * (j))
#define XB_XGEN(j)  (2304 + 64 * (j))
#define XB_TOP      3328
#define XB_TOPGEN   3392
#define XCD_BAR_WORDS 3456
#define XB_SPIN_CAP (1u << 18)
__device__ __forceinline__ unsigned xb_ld(unsigned* p)              { return __hip_atomic_load(p, __ATOMIC_RELAXED, __HIP_MEMORY_SCOPE_AGENT); }
__device__ __forceinline__ unsigned xb_add(unsigned* p, unsigned v) { return __hip_atomic_fetch_add(p, v, __ATOMIC_RELAXED, __HIP_MEMORY_SCOPE_AGENT); }
__device__ __forceinline__ unsigned xb_xcc_id() { return (unsigned)__builtin_amdgcn_s_getreg((3 << 11) | 20) & 0xFu; }
#define XB_SPIN(cond, bar) do { unsigned _sp = 0; while (cond) { __builtin_amdgcn_s_sleep(1); \
    if ((++_sp & 255u) == 0u) { if (xb_ld(&(bar)[XB_TMO])) break; if (_sp > XB_SPIN_CAP) { atomicAdd(&(bar)[XB_TMO], 1u); break; } } } } while (0)

struct XcdBarrier {
    unsigned* bar; unsigned x;
    volatile LAS unsigned* st;
};

__device__ __forceinline__ XcdBarrier xcd_barrier_post(unsigned* bar, volatile LAS unsigned* st) {
    XcdBarrier b; b.bar = bar; b.x = xb_xcc_id(); b.st = st;
    if (threadIdx.x == 0) (void)xb_add(&bar[XB_XCNT(b.x)], 1u);
    return b;
}
__device__ __forceinline__ void xcd_barrier_complete(unsigned* bar, unsigned x, unsigned& nloc, unsigned& nx) {
    const unsigned G = gridDim.x * gridDim.y * gridDim.z;
    unsigned sum, cnt, mine, sp = 0u;
    for (;;) {
        sum = 0u; cnt = 0u; mine = 0u;
#pragma unroll
        for (unsigned j = 0; j < 16; ++j) { const unsigned c = xb_ld(&bar[XB_XCNT(j)]); sum += c; cnt += (c > 0u) ? 1u : 0u; mine = (j == x) ? c : mine; }
        if (sum == G) break;
        __builtin_amdgcn_s_sleep(1);
        if ((++sp & 255u) == 0u) { if (xb_ld(&bar[XB_TMO])) break; if (sp > XB_SPIN_CAP) { atomicAdd(&bar[XB_TMO], 1u); break; } }
    }
    nloc = mine > 0u ? mine : 1u; nx = cnt > 0u ? cnt : 1u;
}

__device__ __forceinline__ void xcd_barrier(const XcdBarrier& b) {
    asm volatile("s_waitcnt vmcnt(0)" ::: "memory");
    __syncthreads();
    if (threadIdx.x == 0) {
        unsigned* bar = b.bar;
        __builtin_amdgcn_s_waitcnt(0);
        unsigned nloc = b.st[0], nx = b.st[1];
        if (nloc == 0u) { xcd_barrier_complete(bar, b.x, nloc, nx); b.st[0] = nloc; b.st[1] = nx; }
        const unsigned old = xb_add(&bar[XB_XSUB(b.x)], 1u);
        const unsigned gen = old / nloc;
        if (old + 1u == (gen + 1u) * nloc) {
            __builtin_amdgcn_fence(__ATOMIC_RELEASE, "agent");
            asm volatile("s_waitcnt vmcnt(0)" ::: "memory");
            const unsigned og = xb_add(&bar[XB_TOP], 1u);
            const unsigned tg = og / nx;
            if (og + 1u == (tg + 1u) * nx) xb_add(&bar[XB_TOPGEN], 1u);
            else XB_SPIN(xb_ld(&bar[XB_TOPGEN]) == tg, bar);
            __builtin_amdgcn_fence(__ATOMIC_ACQUIRE, "agent");
            xb_add(&bar[XB_XGEN(b.x)], 1u);
            asm volatile("s_waitcnt vmcnt(0)" ::: "memory");
        } else {
            XB_SPIN(xb_ld(&bar[XB_XGEN(b.x)]) == gen, bar);
            __builtin_amdgcn_fence(__ATOMIC_ACQUIRE, "agent");
            asm volatile("s_waitcnt vmcnt(0)" ::: "memory");
        }
    }
    __syncthreads();
}


template <class Epi>
__device__ __forceinline__ void run_gemm_sub(LAS unsigned char* lds, const bf16_t* A, const bf16_t* Bt, int M, int N, int K, const Epi& E, int G, int c) {
    const int oz = opaque_zero(); M += oz; N += oz; K += oz;
    pg8::Gemm g{A, Bt, M, N, K}; pg8::StaticOrder S; S.init(M, N, G, c);
    pg8::gemm_phase<Epi, pg8::StaticOrder, GALIGN, GSP2>(lds, g, S, E);
    __syncthreads();
}
template <class Epi>
__device__ __forceinline__ void run_gemm(LAS unsigned char* lds, const bf16_t* A, const bf16_t* Bt, int M, int N, int K, const Epi& E) {
    const int oz = opaque_zero(); M += oz; N += oz; K += oz;
    pg8::Gemm g{A, Bt, M, N, K}; pg8::StaticOrder S; S.init(M, N, (int)gridDim.x, (int)blockIdx.x);
#ifndef NO_GEMM
    pg8::gemm_phase<Epi, pg8::StaticOrder, GALIGN, GSP2>(lds, g, S, E);
#endif
    __syncthreads();
}


#ifdef DBG
__device__ __forceinline__ void dbg16(const bf16_t* p, size_t n, unsigned* flags) {
    unsigned bad = 0; const int tid = opaque_tid();
    for (size_t i = (size_t)blockIdx.x * NT + tid; i < n / 2; i += (size_t)gridDim.x * NT) { const unsigned v = ((const unsigned*)p)[i]; bad += ((v & 0x7F80u) == 0x7F80u) + ((v & 0x7F800000u) == 0x7F800000u); }
    if (bad) atomicAdd(flags, bad);
}
__device__ __forceinline__ void dbg32(const float* p, size_t n, unsigned* flags) {
    unsigned bad = 0; const int tid = opaque_tid();
    for (size_t i = (size_t)blockIdx.x * NT + tid; i < n; i += (size_t)gridDim.x * NT) { const unsigned v = ((const unsigned*)p)[i]; bad += ((v & 0x7F800000u) == 0x7F800000u); }
    if (bad) atomicAdd(flags, bad);
}
#define FLG ((unsigned*)(WSO(WS_MOD) + 1536 * 1024))
#define D16(p, n, bit) do { if (DBG == (bit) && l == 0) { grid.sync(); dbg16((p), (size_t)(n), FLG); } } while (0)
#define D32(p, n, bit) do { if (DBG == (bit) && l == 0) { grid.sync(); dbg32((p), (size_t)(n), FLG); } } while (0)
#define DSTOP(bit) do { if (DBG == (bit) && l == 0) goto dbg_end; } while (0)
#else
#define D16(p, n, bit) do {} while (0)
#define D32(p, n, bit) do {} while (0)
#define DSTOP(bit) do {} while (0)
#endif
#ifdef USE_CG_SYNC
#define GSYNC() grid.sync()
#else
#define GSYNC() do { XcdBarrier xb_; xb_.bar = (unsigned*)(WSO(WS_MOD) + 1792 * 1024); xb_.x = xb_xcc_id(); xb_.st = (volatile LAS unsigned*)(lds + LDS_BYTES - 16); xcd_barrier(xb_); } while (0)
#endif
__global__ void __launch_bounds__(NT, 2) mega_fwd(Args a) {
    extern __shared__ __attribute__((aligned(16))) unsigned char lds_raw[];
    LAS unsigned char* lds = (LAS unsigned char*)lds_raw;
    cg::grid_group grid = cg::this_grid();
    volatile LAS unsigned* xst = (volatile LAS unsigned*)(lds + LDS_BYTES - 16);
    if (threadIdx.x < 4) xst[threadIdx.x] = 0u;
    __syncthreads();
    (void)xcd_barrier_post((unsigned*)(WSO(WS_MOD) + 1792 * 1024), xst);
#define P_(T, off) ((T*)WSO(off))
#define MOD P_(float, WS_MOD)
#define hc P_(float, WS_HC)
#define XN P_(bf16_t, WS_XN)
#define HID P_(bf16_t, WS_HID)
#define U P_(bf16_t, WS_U)
#define QKV P_(bf16_t, WS_QKV)
#define Z P_(bf16_t, WS_Z)
#define G P_(bf16_t, WS_G)
#define AB P_(float, WS_AB)
#define YAP P_(bf16_t, WS_YAP)
#define O0 P_(bf16_t, WS_O0)
#define O1 P_(bf16_t, WS_O1)
#define Y1 P_(bf16_t, WS_FREE)
#define YA P_(bf16_t, WS_FREE)
#define MRG P_(bf16_t, WS_MRG)
#define W1A P_(const bf16_t, WS_W1A)
#define W1B P_(const bf16_t, WS_W1B)
#define WIN P_(const bf16_t, WS_WIN)
#define WGLU P_(const bf16_t, WS_WGLU)
#define WPA P_(const bf16_t, WS_WPA)
#define WPB P_(const bf16_t, WS_WPB)
#define WO P_(const bf16_t, WS_WO)
#define W2A P_(const bf16_t, WS_W2A)
#define W2B P_(const bf16_t, WS_W2B)
#define h ((float*)KARG(32))
#ifndef NO_MOD
    phase_mod(a, lds, MOD);
#endif
    if (blockIdx.x >= 32) {
        phase_convert_part(a, 0, lds, 0, (int)blockIdx.x - 32, (int)gridDim.x - 32);
        phase_convert_part(a, 0, lds, 1, (int)blockIdx.x - 32, (int)gridDim.x - 32);
    }
    if (gridDim.x == 0x7fffffffu) grid.sync();
    GSYNC();
    for (int l = 0; l < DEPTH; ++l) {
        const bool last = (l == DEPTH - 1);
        #define modl (MOD + (size_t)l * 17 * 9216)
        #define src_lat (l == 0 ? INP(0) : h)
#define src_ctx (l == 0 ? INP(2) : hc)
        const int M2 = last ? ML : MALL;
        if (l > 0) phase_convert_part(a, l, lds, 1, (int)blockIdx.x, (int)gridDim.x);
        phase_norm(src_lat, src_ctx, INP(6) + l * D, modl, 0, 1, XN, MALL);
        D32(MOD, 2 * 17 * 9216, 0); D16(W1A, 24 * MiB, 1); D16(XN, (size_t)MALL * D, 2);
        DSTOP(0); DSTOP(1); DSTOP(2);
        GSYNC();
        run_gemm(lds, XN, W1A, MALL, 2 * DFF, D, EpiSwiGLU{HID});
#ifdef REP_UP
        GSYNC();
        run_gemm(lds, XN, W1A, MALL, 2 * DFF, D, EpiSwiGLU{HID});
#endif
        D16(HID, (size_t)MALL * DFF, 3);
        DSTOP(3);
        GSYNC();
#ifndef NO_TAIL
        run_gemm(lds, HID, W1B, ML, D, DFF, EpiResid{src_lat, src_ctx, h, hc, modl + 2 * 1024, 0.5f});
        GSYNC();
        if (blockIdx.x < 64) run_gemm_sub(lds, HID + (size_t)ML * DFF, W1B, MC, D, DFF, EpiResid{src_lat, src_ctx, h, hc, modl + 2 * 1024, 0.5f, ML}, 64, (int)blockIdx.x);
        else phase_norm_range(h, hc, INP(9) + l * D, modl, 3, 4, XN, 0, ML, (int)blockIdx.x - 64, (int)gridDim.x - 64);
        GSYNC();
        phase_norm_range(h, hc, INP(9) + l * D, modl, 3, 4, XN, ML, MALL, (int)blockIdx.x, (int)gridDim.x);
        GSYNC();
#else
        run_gemm(lds, HID, W1B, MALL, D, DFF, EpiResid{src_lat, src_ctx, h, hc, modl + 2 * 1024, 0.5f});
        D32(h, (size_t)ML * D, 4); D32(hc, (size_t)MC * D, 4);
        DSTOP(4);
        GSYNC();
        phase_norm(h, hc, INP(9) + l * D, modl, 3, 4, XN, MALL);
#ifdef REP_NORM
        GSYNC();
        phase_norm(h, hc, INP(9) + l * D, modl, 3, 4, XN, MALL);
#endif
        D16(XN, (size_t)MALL * D, 5);
        DSTOP(5);
        GSYNC();
#endif
        run_gemm(lds, XN, WIN, MALL, NWIN, D, EpiWin{U, QKV, Z, G, AB});
#ifdef REP_WIN
        GSYNC();
        run_gemm(lds, XN, WIN, MALL, NWIN, D, EpiWin{U, QKV, Z, G, AB});
#endif
        D16(U, (size_t)MALL * 512, 6); D16(QKV, (size_t)MALL * 1536, 7); D16(Z, (size_t)MALL * 512, 8); D16(G, (size_t)MALL * 2048, 8); D32(AB, (size_t)MALL * 32, 9);
        DSTOP(6); DSTOP(7); DSTOP(8); DSTOP(9);
        GSYNC();
#ifndef NO_S5
        phase_s5(a, l, lds, U, YAP, Y1);
#ifdef REP_SYNC
        for (int rs = 0; rs < 10; ++rs) GSYNC();
#endif
#ifdef REP_S5
        GSYNC();
        phase_s5(a, l, lds, U, YAP, Y1);
#endif
#endif
        D16(YAP, (size_t)MALL * 512, 10); D16(Y1, (size_t)MALL * 512, 10); D16(O0, (size_t)MALL * 512, 26); D16(O1, (size_t)MALL * 512, 27);
        DSTOP(10); DSTOP(26); DSTOP(27);
        GSYNC();
        phase_s5_combine(YAP, Y1, MALL);
#ifndef NO_GDN
        phase_gdn(a, l, lds, QKV, AB, O0, O1);
#ifdef REP_GDN
        GSYNC();
        phase_gdn(a, l, lds, QKV, AB, O0, O1);
#endif
#endif
        D16(O0, (size_t)MALL * 512, 11); D16(O1, (size_t)MALL * 512, 11); D16(YAP, (size_t)MALL * 512, 12);
        D16(O0, (size_t)MALL * 512, 22); D16(O1, (size_t)MALL * 512, 23); D16(O0, (size_t)ML * 512, 24); D16(O1, (size_t)ML * 512, 25);
        DSTOP(11); DSTOP(12); DSTOP(20); DSTOP(21); DSTOP(22); DSTOP(23); DSTOP(24); DSTOP(25);
        GSYNC();
        if (last) phase_gdn_finish(O0, O1, Z, INP(24) + l * 64, M2, (int)blockIdx.x, (int)gridDim.x);
        else if (blockIdx.x >= 32) phase_gdn_finish(O0, O1, Z, INP(24) + l * 64, M2, (int)blockIdx.x - 32, (int)gridDim.x - 32);
        run_gemm(lds, YAP, WGLU, M2, 512, 512, EpiGLU{YAP, YA, INP(20) + l * 512});
        D16(O0, (size_t)M2 * 512, 13); D16(YA, (size_t)M2 * 512, 13);
        DSTOP(13);
        GSYNC();
        run_gemm(lds, YA, WPA, M2, D, 512, EpiMerge<0>{G, MRG});
        run_gemm(lds, O0, WPB, M2, D, 512, EpiMerge<1>{G, MRG});
        D16(MRG, (size_t)M2 * D, 14);
        DSTOP(14);
        GSYNC();
        run_gemm(lds, MRG, WO, M2, D, D, EpiResid{h, hc, h, hc, modl + 5 * 1024, 1.0f});
        if (!last && blockIdx.x >= 64) phase_convert_part(a, l + 1, lds, 0, (int)blockIdx.x - 64, (int)gridDim.x - 64);
        D32(h, (size_t)ML * D, 15);
        DSTOP(15);
        GSYNC();
        phase_norm(h, hc, INP(28) + l * D, modl, 6, 7, XN, M2);
        GSYNC();
        run_gemm(lds, XN, W2A, M2, 2 * DFF, D, EpiSwiGLU{HID});
        D16(HID, (size_t)M2 * DFF, 16);
        DSTOP(16);
        GSYNC();
        run_gemm(lds, HID, W2B, M2, D, DFF, EpiResid{h, hc, h, hc, modl + 8 * 1024, 0.5f});
        D32(h, (size_t)ML * D, 17);
        DSTOP(17);
        GSYNC();
    }
#ifdef DBG
    dbg_end:
    GSYNC();
    { float* o = h; const int tid = opaque_tid();
      for (size_t i = (size_t)blockIdx.x * NT + tid; i < (size_t)ML * D; i += (size_t)gridDim.x * NT) o[i] = 0.f;
      GSYNC();
      if (blockIdx.x == 0 && tid == 0) { const unsigned f = *FLG; int c = 0; if (f) c = (DBG == 20 || DBG == 21) ? (int)f : 32 - __clz((int)f); o[0] = 5792.6f * (float)c; } }
#else
    phase_final(h, INP(31));
#endif
}

extern "C" void kernel_launch(void* const* d_in, const int* in_sizes, int n_in, void* d_out, int out_size, void* d_ws, size_t ws_size, hipStream_t stream) {
    static int grid_blocks = 0;
    if (grid_blocks == 0) {
        if (n_in != 32 || ws_size < WS_END) { fprintf(stderr, "kernel_launch: unexpected inputs (n_in %d, ws %zu)\n", n_in, ws_size); grid_blocks = -1; return; }
        int dev = 0, cus = 0, per_cu = 0;
        hipGetDevice(&dev);
        hipDeviceGetAttribute(&cus, hipDeviceAttributeMultiprocessorCount, dev);
        if (hipFuncSetAttribute((const void*)mega_fwd, hipFuncAttributeMaxDynamicSharedMemorySize, LDS_BYTES) != hipSuccess) { fprintf(stderr, "kernel_launch: hipFuncSetAttribute failed\n"); grid_blocks = -1; return; }
        if (hipOccupancyMaxActiveBlocksPerMultiprocessor(&per_cu, (const void*)mega_fwd, NT, LDS_BYTES) != hipSuccess || per_cu < 1) { fprintf(stderr, "kernel_launch: occupancy query gave %d\n", per_cu); per_cu = 1; }
        (void)hipGetLastError();
        grid_blocks = cus * 1;
        if (cus != 256) { fprintf(stderr, "kernel_launch: built for a 256-CU device (got %d)\n", cus); grid_blocks = -1; return; }
    }
    if (grid_blocks < 0) return;
#ifdef DBG
    hipMemsetAsync((char*)d_ws + 1536 * 1024, 0, 256, stream);
#endif
    hipMemsetAsync((char*)d_ws + 1792 * 1024, 0, 16384, stream);
    Args a{};
    for (int i = 0; i < 32; ++i) a.in[i] = (const float*)d_in[i];
    a.in[32] = (const float*)d_out; a.in[33] = (const float*)d_ws;
    void* args[] = {&a};
    hipError_t e = hipLaunchCooperativeKernel((const void*)mega_fwd, dim3(grid_blocks), dim3(NT), args, LDS_BYTES, stream);
    if (e != hipSuccess) fprintf(stderr, "cooperative launch failed: %s (grid %d)\n", hipGetErrorString(e), grid_blocks);
}
```
